# Optimizing an MI355X kernel written in HIP

```python
import jax, jax.numpy as jnp
from jax import lax
import numpy as np

D_MODEL = 1024
BATCH = 8
SEQ = 2048
DEPTH = 2

GRID_W = 64
CTX_LEN = 256
N_MIXERS = 2
N_RET_LAYERS = (DEPTH + 1) // 2
N_SWA_LAYERS = DEPTH // 2
NORM_EPS = 1e-6
RET_HEADS = D_MODEL // 256
RET_DK = D_MODEL // RET_HEADS
RET_DV = 2 * RET_DK
RET_CHUNK = 128
SWA_HEAD_DIM = 64
SWA_Q_HEADS = D_MODEL // SWA_HEAD_DIM
SWA_KV_HEADS = 2
SWA_WINDOW = 128
SWA_BLOCK = SWA_WINDOW
ROPE_BASE = 10000.0
N_EXPERTS = 16
EC_CAPACITY = 2
EXPERT_FF = 2 * D_MODEL

kernel_name = "hybrid_retention_swa_ec_moe_dit"


def rmsnorm(x, g):
    xf = x.astype(jnp.float32)
    xf = xf * lax.rsqrt(jnp.mean(xf * xf, axis=-1, keepdims=True) + NORM_EPS)
    return (xf * g.astype(jnp.float32)).astype(x.dtype)


def adaln_modulation(cond, w, b):
    m = jax.nn.silu(cond) @ w + b
    return jnp.split(m[..., None, :], 6, axis=-1)


def modulate(h, shift, scale):
    return h * (1.0 + scale) + shift


def axial_rope_tables(n_tokens):
    rows = n_tokens // GRID_W
    row = jnp.repeat(jnp.arange(rows), GRID_W).astype(jnp.float32)
    col = jnp.tile(jnp.arange(GRID_W), rows).astype(jnp.float32)
    n_freq = SWA_HEAD_DIM // 4
    inv_freq = ROPE_BASE ** (-jnp.arange(n_freq, dtype=jnp.float32) / n_freq)
    ang = jnp.stack([row[:, None] * inv_freq, col[:, None] * inv_freq], axis=1)
    return jnp.cos(ang), jnp.sin(ang)


def apply_axial_rope(x, cos, sin):
    xr = x.reshape(x.shape[:-1] + (2, 2, SWA_HEAD_DIM // 4)).astype(jnp.float32)
    x1, x2 = xr[..., 0, :], xr[..., 1, :]
    c, s = cos[:, None], sin[:, None]
    out = jnp.stack([x1 * c - x2 * s, x2 * c + x1 * s], axis=-2)
    return out.reshape(x.shape).astype(x.dtype)


def retention_chunkwise(q, k, v, log_gamma, state0):
    b, h, t, _ = q.shape
    dv = v.shape[-1]
    n = t // RET_CHUNK

    def chunks(a):
        return jnp.moveaxis(a.astype(jnp.float32).reshape(b, h, n, RET_CHUNK, a.shape[-1]), 2, 0)

    pos = jnp.arange(RET_CHUNK, dtype=jnp.float32)
    diff = pos[:, None] - pos[None, :]
    lg = log_gamma.astype(jnp.float32)[:, None, None]
    intra_decay = jnp.where(diff >= 0, jnp.exp(jnp.maximum(diff, 0.0) * lg), 0.0)
    q_decay = jnp.exp((pos + 1.0) * lg[:, :, 0])[:, :, None]
    k_decay = jnp.exp((RET_CHUNK - 1.0 - pos) * lg[:, :, 0])[:, :, None]
    chunk_decay = jnp.exp(RET_CHUNK * lg)

    def step(state, qkv):
        qc, kc, vc = qkv
        scores = jnp.einsum('bhqd,bhkd->bhqk', qc, kc) * intra_decay
        o = (jnp.einsum('bhqk,bhkv->bhqv', scores, vc)
             + jnp.einsum('bhqd,bhdv->bhqv', qc, state) * q_decay)
        state = chunk_decay * state + jnp.einsum('bhkd,bhkv->bhdv', kc * k_decay, vc)
        return state, o

    state, o = lax.scan(step, state0, (chunks(q), chunks(k), chunks(v)))
    return jnp.moveaxis(o, 0, 2).reshape(b, h, t, dv), state


def retention_final_state(k, v, log_gamma):
    t = k.shape[2]
    w = jnp.exp((t - 1.0 - jnp.arange(t, dtype=jnp.float32))[None, :] * log_gamma[:, None])
    return jnp.einsum('bhtd,bhtv->bhdv', k.astype(jnp.float32) * w[..., None], v.astype(jnp.float32))


def head_groupnorm(o, gain):
    mu = jnp.mean(o, axis=-1, keepdims=True)
    var = jnp.mean(jnp.square(o - mu), axis=-1, keepdims=True)
    o = (o - mu) * lax.rsqrt(var + NORM_EPS)
    b, h, t, dv = o.shape
    return o.transpose(0, 2, 1, 3).reshape(b, t, h * dv) * gain.astype(jnp.float32)


def retention_mixer(h_lat, h_ctx, w_in, decay_f, decay_b, gn_f, gn_b, w_out, need_ctx_out):
    hk, hv = RET_HEADS * RET_DK, RET_HEADS * RET_DV
    k0, v0, gf0, gb0 = hk, 2 * hk, 2 * hk + hv, 2 * hk + 2 * hv
    lg_f = jax.nn.log_sigmoid(decay_f.astype(jnp.float32))
    lg_b = jax.nn.log_sigmoid(decay_b.astype(jnp.float32))

    def heads(a, dh):
        return a.reshape(a.shape[0], a.shape[1], RET_HEADS, dh).transpose(0, 2, 1, 3)

    def flip(a):
        return jnp.flip(a, axis=2)

    def gated_out(o_f, o_b, g_f, g_b):
        y = (jax.nn.silu(g_f.astype(jnp.float32)) * head_groupnorm(o_f, gn_f)
             + jax.nn.silu(g_b.astype(jnp.float32)) * head_groupnorm(o_b, gn_b))
        return y.astype(w_out.dtype) @ w_out

    zero = jnp.zeros((h_ctx.shape[0], RET_HEADS, RET_DK, RET_DV), jnp.float32)
    if need_ctx_out:
        pc = h_ctx @ w_in
        qc = heads(pc[..., :k0], RET_DK) * RET_DK ** -0.5
        kc, vc = heads(pc[..., k0:v0], RET_DK), heads(pc[..., v0:gf0], RET_DV)
        oc_f, sc_f = retention_chunkwise(qc, kc, vc, lg_f, zero)
        oc_b, sc_b = retention_chunkwise(flip(qc), flip(kc), flip(vc), lg_b, zero)
        y_ctx = gated_out(oc_f, flip(oc_b), pc[..., gf0:gb0], pc[..., gb0:])
    else:
        pc = h_ctx @ w_in[:, k0:gf0]
        kc, vc = heads(pc[..., :hk], RET_DK), heads(pc[..., hk:], RET_DV)
        sc_f = retention_final_state(kc, vc, lg_f)
        sc_b = retention_final_state(flip(kc), flip(vc), lg_b)
        y_ctx = None
    p = h_lat @ w_in
    q = heads(p[..., :k0], RET_DK) * RET_DK ** -0.5
    k, v = heads(p[..., k0:v0], RET_DK), heads(p[..., v0:gf0], RET_DV)
    o_f, _ = retention_chunkwise(q, k, v, lg_f, sc_f)
    o_b, _ = retention_chunkwise(flip(q), flip(k), flip(v), lg_b, sc_b)
    y_lat = gated_out(o_f, flip(o_b), p[..., gf0:gb0], p[..., gb0:])
    return y_lat, y_ctx


def softmax_with_sink(scores, sink):
    s = jnp.concatenate([scores, jnp.broadcast_to(sink, scores.shape[:-1] + (1,))], axis=-1)
    return jax.nn.softmax(s, axis=-1)[..., :-1]


def window_attention_mixer(h_lat, h_ctx, w_qkv, sink, w_out, need_ctx_out):
    b, t, _ = h_lat.shape
    n_ctx = h_ctx.shape[1]
    H, KV, hd = SWA_Q_HEADS, SWA_KV_HEADS, SWA_HEAD_DIM
    G = H // KV
    qw, kw = H * hd, KV * hd
    scale = hd ** -0.5
    sink_kg = sink.astype(jnp.float32).reshape(KV, G)

    p = h_lat @ w_qkv
    cos, sin = axial_rope_tables(t)
    q = apply_axial_rope(p[..., :qw].reshape(b, t, H, hd), cos, sin) * scale
    k = apply_axial_rope(p[..., qw:qw + kw].reshape(b, t, KV, hd), cos, sin)
    v = p[..., qw + kw:].reshape(b, t, KV, hd)

    if need_ctx_out:
        pc = h_ctx @ w_qkv
        qc = pc[..., :qw].reshape(b, n_ctx, KV, G, hd) * scale
        kvc = pc[..., qw:]
    else:
        kvc = h_ctx @ w_qkv[:, qw:]
    kc = kvc[..., :kw].reshape(b, n_ctx, KV, hd)
    vc = kvc[..., kw:].reshape(b, n_ctx, KV, hd)

    nb = t // SWA_BLOCK
    qb = q.reshape(b, nb, SWA_BLOCK, KV, G, hd)

    def band(a):
        a = jnp.pad(a.reshape(b, nb, SWA_BLOCK, KV, hd), ((0, 0), (1, 1), (0, 0), (0, 0), (0, 0)))
        return jnp.concatenate([a[:, :-2], a[:, 1:-1], a[:, 2:]], axis=2)

    kb, vb = band(k), band(v)
    blk = jnp.arange(nb)[:, None, None]
    qpos = blk * SWA_BLOCK + jnp.arange(SWA_BLOCK)[None, :, None]
    kpos = (blk - 1) * SWA_BLOCK + jnp.arange(3 * SWA_BLOCK)[None, None, :]
    valid = (jnp.abs(qpos - kpos) <= SWA_WINDOW) & (kpos >= 0) & (kpos < t)

    s_win = jnp.einsum('bnqkgd,bnskd->bnkgqs', qb, kb).astype(jnp.float32)
    s_win = jnp.where(valid[None, :, None, None], s_win, -jnp.inf)
    s_ctx = jnp.einsum('bnqkgd,bckd->bnkgqc', qb, kc).astype(jnp.float32)
    probs = softmax_with_sink(jnp.concatenate([s_ctx, s_win], axis=-1),
                              sink_kg[None, None, :, :, None, None]).astype(v.dtype)
    o = (jnp.einsum('bnkgqc,bckd->bnqkgd', probs[..., :n_ctx], vc)
         + jnp.einsum('bnkgqs,bnskd->bnqkgd', probs[..., n_ctx:], vb))
    y_lat = o.reshape(b, t, qw) @ w_out

    if need_ctx_out:
        s_c = jnp.einsum('bqkgd,bckd->bkgqc', qc, kc).astype(jnp.float32)
        pr_c = softmax_with_sink(s_c, sink_kg[None, :, :, None, None]).astype(vc.dtype)
        y_ctx = jnp.einsum('bkgqc,bckd->bqkgd', pr_c, vc).reshape(b, n_ctx, qw) @ w_out
    else:
        y_ctx = None
    return y_lat, y_ctx


def expert_choice_moe(h, w_router, w_gate, w_up, w_down):
    b, t, d = h.shape
    cap = EC_CAPACITY * t // N_EXPERTS
    affinity = jax.nn.softmax((h @ w_router).astype(jnp.float32), axis=-1)
    gate, idx = lax.top_k(jnp.swapaxes(affinity, 1, 2), cap)
    xs = jax.vmap(lambda hb, ib: hb[ib])(h, idx)
    hid = (jax.nn.silu(jnp.einsum('becd,edf->becf', xs, w_gate))
           * jnp.einsum('becd,edf->becf', xs, w_up))
    ys = jnp.einsum('becf,efd->becd', hid, w_down) * gate[..., None].astype(h.dtype)
    return jax.vmap(lambda yb, ib: jnp.zeros((t, d), yb.dtype).at[ib.reshape(-1)].add(yb.reshape(-1, d)))(ys, idx)


def setup_inputs(seed: int = 0) -> dict:
    key = jax.random.key(seed)
    ks = jax.random.split(key, 24)
    f32 = jnp.float32

    def normal(k, shape, scale):
        return jax.random.normal(k, shape, f32) * scale

    hk, hv = RET_HEADS * RET_DK, RET_HEADS * RET_DV
    ret_cols = 2 * hk + 3 * hv
    swa_cols = (SWA_Q_HEADS + 2 * SWA_KV_HEADS) * SWA_HEAD_DIM
    gamma = 1.0 - 2.0 ** (-5.0 - jnp.arange(RET_HEADS, dtype=f32))
    decay_logit = jnp.log(gamma) - jnp.log1p(-gamma)
    return {
        "x": normal(ks[0], (BATCH, SEQ, D_MODEL), 1.0),
        "c": normal(ks[1], (BATCH, D_MODEL), 1.0),
        "ctx": normal(ks[2], (BATCH, CTX_LEN, D_MODEL), 1.0),
        "c_ctx": normal(ks[3], (D_MODEL,), 1.0),
        "ada_w": normal(ks[4], (DEPTH, D_MODEL, 6 * D_MODEL), D_MODEL ** -0.5),
        "ada_b": normal(ks[5], (DEPTH, 6 * D_MODEL), 0.01),
        "norm1_g": 1.0 + normal(ks[6], (DEPTH, D_MODEL), 0.02),
        "norm2_g": 1.0 + normal(ks[7], (DEPTH, D_MODEL), 0.02),
        "final_g": 1.0 + normal(ks[8], (D_MODEL,), 0.02),
        "ret_w_in": normal(ks[9], (N_RET_LAYERS, D_MODEL, ret_cols), D_MODEL ** -0.5),
        "ret_decay_f": decay_logit + normal(ks[10], (N_RET_LAYERS, RET_HEADS), 0.1),
        "ret_decay_b": decay_logit + normal(ks[11], (N_RET_LAYERS, RET_HEADS), 0.1),
        "ret_gn_f": 1.0 + normal(ks[12], (N_RET_LAYERS, hv), 0.02),
        "ret_gn_b": 1.0 + normal(ks[13], (N_RET_LAYERS, hv), 0.02),
        "ret_w_out": normal(ks[14], (N_RET_LAYERS, hv, D_MODEL), hv ** -0.5),
        "swa_w_qkv": normal(ks[15], (N_SWA_LAYERS, D_MODEL, swa_cols), D_MODEL ** -0.5),
        "swa_sink": normal(ks[16], (N_SWA_LAYERS, SWA_Q_HEADS), 0.5),
        "swa_w_out": normal(ks[17], (N_SWA_LAYERS, SWA_Q_HEADS * SWA_HEAD_DIM, D_MODEL), (SWA_Q_HEADS * SWA_HEAD_DIM) ** -0.5),
        "moe_router": normal(ks[18], (DEPTH, D_MODEL, N_EXPERTS), D_MODEL ** -0.5),
        "moe_w_gate": normal(ks[19], (DEPTH, N_EXPERTS, D_MODEL, EXPERT_FF), D_MODEL ** -0.5),
        "moe_w_up": normal(ks[20], (DEPTH, N_EXPERTS, D_MODEL, EXPERT_FF), D_MODEL ** -0.5),
        "moe_w_down": normal(ks[21], (DEPTH, N_EXPERTS, EXPERT_FF, D_MODEL), EXPERT_FF ** -0.5),
    }


def reference(x, c, ctx, c_ctx, ada_w, ada_b, norm1_g, norm2_g, final_g,
              ret_w_in, ret_decay_f, ret_decay_b, ret_gn_f, ret_gn_b, ret_w_out,
              swa_w_qkv, swa_sink, swa_w_out,
              moe_router, moe_w_gate, moe_w_up, moe_w_down):
    for i in range(DEPTH):
        last = i == DEPTH - 1
        j = i // N_MIXERS
        sh1, sc1, g1, sh2, sc2, g2 = adaln_modulation(c, ada_w[i], ada_b[i])
        csh1, csc1, cg1, csh2, csc2, cg2 = adaln_modulation(c_ctx, ada_w[i], ada_b[i])
        hx = modulate(rmsnorm(x, norm1_g[i]), sh1, sc1)
        hc = modulate(rmsnorm(ctx, norm1_g[i]), csh1, csc1)
        if i % N_MIXERS == 0:
            yx, yc = retention_mixer(hx, hc, ret_w_in[j], ret_decay_f[j], ret_decay_b[j],
                                     ret_gn_f[j], ret_gn_b[j], ret_w_out[j], not last)
        else:
            yx, yc = window_attention_mixer(hx, hc, swa_w_qkv[j], swa_sink[j], swa_w_out[j], not last)
        x = x + g1 * yx
        hx = modulate(rmsnorm(x, norm2_g[i]), sh2, sc2)
        x = x + g2 * expert_choice_moe(hx, moe_router[i], moe_w_gate[i], moe_w_up[i], moe_w_down[i])
        if not last:
            ctx = ctx + cg1 * yc
            hc = modulate(rmsnorm(ctx, norm2_g[i]), csh2, csc2)
            ctx = ctx + cg2 * expert_choice_moe(hc, moe_router[i], moe_w_gate[i], moe_w_up[i], moe_w_down[i])
    return rmsnorm(x, final_g)
```

```cpp
#include <hip/hip_runtime.h>
#include <cstdio>
#include <cstdint>

#ifndef MK_ONE_LAUNCH
#define MK_ONE_LAUNCH 1
#endif

#define LAS __attribute__((address_space(3)))
typedef unsigned short bf16_t;
typedef short bf16x8 __attribute__((ext_vector_type(8)));
typedef short s16x4 __attribute__((ext_vector_type(4)));
typedef float f32x4 __attribute__((ext_vector_type(4)));
typedef float f32x2 __attribute__((ext_vector_type(2)));
typedef unsigned u32x4 __attribute__((ext_vector_type(4)));
typedef unsigned u32x2 __attribute__((ext_vector_type(2)));

constexpr int NB = 8, T = 2048, D = 1024, TC = 256;
constexpr int NLAT = NB * T;
constexpr int NCTX = NB * TC;
constexpr int NROW = NLAT + NCTX;
constexpr int NE = 16, FF = 2048;
constexpr int QKG_LD = 6144;
constexpr int QKV_LD = 1280;
constexpr float LOG2E = 1.4426950408889634f;

constexpr size_t MiB = 1u << 20;
constexpr size_t WS_CTL = 0;
constexpr size_t CTL_BYTES = 64 * 1024;
constexpr size_t WS_MOD = 1 * MiB;
constexpr size_t WS_ROPE = 1 * MiB + 512 * 1024;
constexpr size_t WS_WQKG = 2 * MiB;
constexpr size_t WS_WV = 14 * MiB;
constexpr size_t WS_WRO = 18 * MiB;
constexpr size_t WS_WQKV = 22 * MiB;
constexpr size_t WS_WSO = 25 * MiB;
constexpr size_t WS_AFF = 27 * MiB;
constexpr size_t WS_TOK = 29 * MiB;
constexpr size_t WS_GATE = WS_TOK + 36864 * 4;
constexpr size_t WS_INV = WS_GATE + 36864 * 4;
constexpr size_t WS_GNST = 31 * MiB;
constexpr size_t WS_HBUF = 36 * MiB;
constexpr size_t WS_XR = 72 * MiB;
constexpr size_t WS_GU = 144 * MiB;
constexpr size_t WS_DW = 400 * MiB;
constexpr size_t WS_H2 = WS_GU + 128 * MiB;
constexpr size_t WS_R = 528 * MiB;
constexpr size_t WS_END = 960 * MiB;
constexpr size_t R_QKG = WS_R;
constexpr size_t R_VT = WS_R + 216 * MiB;
constexpr size_t R_OF = WS_R + 288 * MiB;
constexpr size_t R_OB = WS_R + 360 * MiB;
constexpr size_t R_XRP = WS_XR + 36 * MiB;
constexpr size_t R_YS2 = WS_R + 288 * MiB;
constexpr size_t R_XS = WS_R;
constexpr size_t R_HID = WS_R + 72 * MiB;
constexpr size_t R_YS = WS_R + 216 * MiB;
constexpr size_t R_QKV = WS_R;
constexpr size_t R_O1 = WS_R + 48 * MiB;

constexpr int LDS_BYTES = 147456;
constexpr int LDS_MISC = 147456 - 64;

typedef __bf16 bf16x2_t __attribute__((ext_vector_type(2)));
__device__ __forceinline__ unsigned cvt_pk_bf16(float lo, float hi) { const f32x2 v = {lo, hi}; const bf16x2_t b = __builtin_convertvector(v, bf16x2_t); return __builtin_bit_cast(unsigned, b); }
__device__ __forceinline__ float bf_lo(unsigned w) { return __uint_as_float(w << 16); }
__device__ __forceinline__ float bf_hi(unsigned w) { return __uint_as_float(w & 0xffff0000u); }
__device__ __forceinline__ float wave_sum(float v) {
#pragma unroll
    for (int o = 1; o < 64; o <<= 1) v += __shfl_xor(v, o);
    return v;
}
__device__ __forceinline__ float sum_x16x32(float x) {
    auto a = __builtin_amdgcn_permlane32_swap(__float_as_uint(x), __float_as_uint(x), false, false); x = __uint_as_float(a[0]) + __uint_as_float(a[1]);
    auto b = __builtin_amdgcn_permlane16_swap(__float_as_uint(x), __float_as_uint(x), false, false); return __uint_as_float(b[0]) + __uint_as_float(b[1]);
}
__device__ __forceinline__ float max_x16x32(float x) {
    auto a = __builtin_amdgcn_permlane32_swap(__float_as_uint(x), __float_as_uint(x), false, false); x = fmaxf(__uint_as_float(a[0]), __uint_as_float(a[1]));
    auto b = __builtin_amdgcn_permlane16_swap(__float_as_uint(x), __float_as_uint(x), false, false); return fmaxf(__uint_as_float(b[0]), __uint_as_float(b[1]));
}
__device__ __forceinline__ void wg_sync() { asm volatile("s_waitcnt vmcnt(0) lgkmcnt(0)" ::: "memory"); __builtin_amdgcn_s_barrier(); asm volatile("" ::: "memory"); }
__device__ __forceinline__ void wg_sync_lds() { asm volatile("s_waitcnt lgkmcnt(0)" ::: "memory"); __builtin_amdgcn_s_barrier(); asm volatile("" ::: "memory"); }
__device__ __forceinline__ float silu_f(float x) { return x * __builtin_amdgcn_rcpf(1.0f + __builtin_amdgcn_exp2f(-x * LOG2E)); }

constexpr float FP8_SX = 16.0f, FP8_SW = 256.0f, FP8_SH = 8.0f, FP8_SO = 32.0f;
__device__ __forceinline__ float clamp448(float x) { return __builtin_fminf(__builtin_fmaxf(x, -448.0f), 448.0f); }
__device__ __forceinline__ unsigned pk4_fp8(float a, float b, float c, float d) { int w = 0; w = __builtin_amdgcn_cvt_pk_fp8_f32(clamp448(a), clamp448(b), w, false); w = __builtin_amdgcn_cvt_pk_fp8_f32(clamp448(c), clamp448(d), w, true); return (unsigned)w; }
#define XB_TMO      128
#define XB_XCNT(j)  (256  + 64 * (j))
#define XB_XSUB(j)  (1280 + 64 * (j))
#define XB_XGEN(j)  (2304 + 64 * (j))
#define XB_TOP      3328
#define XB_TOPGEN   3392
#define XCD_BAR_WORDS 3456
#define XB_SPIN_CAP (1u << 18)
__device__ __forceinline__ unsigned xb_ld(unsigned* p)              { return __hip_atomic_load(p, __ATOMIC_RELAXED, __HIP_MEMORY_SCOPE_AGENT); }
__device__ __forceinline__ unsigned xb_add(unsigned* p, unsigned v) { return __hip_atomic_fetch_add(p, v, __ATOMIC_RELAXED, __HIP_MEMORY_SCOPE_AGENT); }
__device__ __forceinline__ unsigned xb_xcc_id() { return (unsigned)__builtin_amdgcn_s_getreg((3 << 11) | 20) & 0xFu; }
#define XB_SPIN(cond, bar) do { unsigned _sp = 0; while (cond) { __builtin_amdgcn_s_sleep(1); \
    if ((++_sp & 255u) == 0u) { if (xb_ld(&(bar)[XB_TMO])) break; if (_sp > XB_SPIN_CAP) { atomicAdd(&(bar)[XB_TMO], 1u); break; } } } } while (0)
struct XcdBarrier { unsigned* bar; unsigned x; volatile LAS unsigned* st; };
__device__ __forceinline__ XcdBarrier xcd_barrier_post(unsigned* bar, volatile LAS unsigned* st) {
    XcdBarrier b; b.bar = bar; b.x = xb_xcc_id(); b.st = st;
    if (threadIdx.x == 0) (void)xb_add(&bar[XB_XCNT(b.x)], 1u);
    return b;
}
__device__ __forceinline__ void xcd_barrier_complete(unsigned* bar, unsigned x, unsigned& nloc, unsigned& nx) {
    const unsigned G = gridDim.x * gridDim.y * gridDim.z;
    unsigned sum, cnt, mine, sp = 0u;
    for (;;) {
        sum = 0u; cnt = 0u; mine = 0u;
#pragma unroll
        for (unsigned j = 0; j < 16; ++j) { const unsigned c = xb_ld(&bar[XB_XCNT(j)]); sum += c; cnt += (c > 0u) ? 1u : 0u; mine = (j == x) ? c : mine; }
        if (sum == G) break;
        __builtin_amdgcn_s_sleep(1);
        if ((++sp & 255u) == 0u) { if (xb_ld(&bar[XB_TMO])) break; if (sp > XB_SPIN_CAP) { atomicAdd(&bar[XB_TMO], 1u); break; } }
    }
    nloc = mine > 0u ? mine : 1u; nx = cnt > 0u ? cnt : 1u;
}
__device__ __forceinline__ void xcd_barrier(const XcdBarrier& b) {
    asm volatile("s_waitcnt vmcnt(0)" ::: "memory");
    __syncthreads();
    if (threadIdx.x == 0) {
        unsigned* bar = b.bar;
        __builtin_amdgcn_s_waitcnt(0);
        unsigned nloc = b.st[0], nx = b.st[1];
        if (nloc == 0u) { xcd_barrier_complete(bar, b.x, nloc, nx); b.st[0] = nloc; b.st[1] = nx; }
        const unsigned old = xb_add(&bar[XB_XSUB(b.x)], 1u);
        const unsigned gen = old / nloc;
        if (old + 1u == (gen + 1u) * nloc) {
            __builtin_amdgcn_fence(__ATOMIC_RELEASE, "agent");
            asm volatile("s_waitcnt vmcnt(0)" ::: "memory");
            const unsigned og = xb_add(&bar[XB_TOP], 1u);
            const unsigned tg = og / nx;
            if (og + 1u == (tg + 1u) * nx) xb_add(&bar[XB_TOPGEN], 1u);
            else XB_SPIN(xb_ld(&bar[XB_TOPGEN]) == tg, bar);
            __builtin_amdgcn_fence(__ATOMIC_ACQUIRE, "agent");
            xb_add(&bar[XB_XGEN(b.x)], 1u);
            asm volatile("s_waitcnt vmcnt(0)" ::: "memory");
        } else {
            XB_SPIN(xb_ld(&bar[XB_XGEN(b.x)]) == gen, bar);
            __builtin_amdgcn_fence(__ATOMIC_ACQUIRE, "agent");
            asm volatile("s_waitcnt vmcnt(0)" ::: "memory");
        }
    }
    __syncthreads();
}

#define GB_XTAB   8448
#define GB_CTR(g) (8704 + 64 * (g))
__device__ __forceinline__ void grp_barrier(unsigned* bar, volatile LAS unsigned* st) {
    asm volatile("s_waitcnt vmcnt(0)" ::: "memory");
    __syncthreads();
    if (threadIdx.x == 0) {
        const unsigned g = blockIdx.x & 7u, nmem = gridDim.x >> 3;
        __builtin_amdgcn_s_waitcnt(0);
        unsigned loc = st[2];
        if (loc == 0u) { const unsigned mine = xb_xcc_id() + 1u; unsigned ok = 1u;
            for (unsigned k = 0; k < nmem; ++k) ok &= (xb_ld(&bar[GB_XTAB + g + 8u * k]) == mine) ? 1u : 0u;
            loc = ok ? 1u : 2u; st[2] = loc; }
        if (loc == 2u) { __builtin_amdgcn_fence(__ATOMIC_RELEASE, "agent"); asm volatile("s_waitcnt vmcnt(0)" ::: "memory"); }
        const unsigned n = st[3] + 1u; st[3] = n;
        const unsigned target = n * nmem;
        (void)xb_add(&bar[GB_CTR(g)], 1u);
        XB_SPIN(xb_ld(&bar[GB_CTR(g)]) < target, bar);
        __builtin_amdgcn_fence(__ATOMIC_ACQUIRE, "agent");
        asm volatile("s_waitcnt vmcnt(0)" ::: "memory");
    }
    __syncthreads();
}

namespace pg8 {
constexpr int BM = 256, BK = 64, HALF = 128, HTB = HALF * BK * 2, STAGE_BYTES = 8 * HTB;
__device__ __forceinline__ int lds_byte(int r, int c) { const int st = (r >> 4) * 2 + (c >> 5), rr = r & 15, cc = c & 31, ob = rr * 64 + cc * 2; return st * 1024 + (ob ^ (((ob >> 9) & 1) << 5)); }
__device__ __forceinline__ void stage_rc(int b, int& R, int& C) { const int st = b / 1024, sb = b % 1024, swz = sb ^ (((sb >> 9) & 1) << 5); R = (st >> 1) * 16 + swz / 64; C = (st & 1) * 32 + (swz % 64) / 2; }
__device__ __forceinline__ int perm32(int rho) { const int n = rho >> 4, i = rho & 15; return 8 * (i >> 2) + 4 * n + (i & 3); }
struct Unit { int pm, pn, aux; };
struct Gemm { int lda, ldb; };
__device__ __forceinline__ void tile_order(int wgid, int nM, int nN, int& pm, int& pn) {
    const int nwg = nM * nN;
    { const int q = nwg / 8, r = nwg % 8, xcd = wgid % 8, off = wgid / 8; wgid = (xcd < r ? xcd * (q + 1) : r * (q + 1) + (xcd - r) * q) + off; }
    const int nig = 8 * nN, gid = wgid / nig, fm = gid * 8, gsz = (nM - fm) < 8 ? (nM - fm) : 8;
    pm = fm + ((wgid % nig) % gsz); pn = (wgid % nig) / gsz;
}
typedef int v4i_t __attribute__((ext_vector_type(4)));
typedef int v8i_t __attribute__((ext_vector_type(8)));
__device__ __forceinline__ v8i_t cat_frag(bf16x8 a, bf16x8 b) { return __builtin_shufflevector(__builtin_bit_cast(v4i_t, a), __builtin_bit_cast(v4i_t, b), 0, 1, 2, 3, 4, 5, 6, 7); }
template <class Epi, class Sched, bool FP8 = false>
__device__ __forceinline__ void gemm_phase(LAS unsigned char* lds, const Gemm g, const Sched& S, const Epi& E) {
    const int tid = threadIdx.x, wid = __builtin_amdgcn_readfirstlane(tid >> 6), lane = tid & 63, wr = wid >> 2, wc = wid & 3, fr = lane & 15, fq = lane >> 4;
    unsigned voffA[2], voffB[2];
#pragma unroll
    for (int i = 0; i < 2; ++i) { int R, C; stage_rc(tid * 16 + i * 8192, R, C); const int Rb = Epi::PERM ? ((R & ~31) + perm32(R & 31)) : R;
        voffA[i] = (unsigned)(R * g.lda + C) * 2u; voffB[i] = (unsigned)(Rb * g.ldb + C) * 2u; }
    const size_t kstep = (size_t)(BK * 2);
    const size_t hstepA = (size_t)HALF * g.lda * 2, hstepB = (size_t)HALF * g.ldb * 2;
    const unsigned ldsw = (unsigned)wid * 1024u;
    const int aoff = lds_byte(wr * 64 + fr, fq * 8), boff = lds_byte(wc * 32 + fr, fq * 8);
#define PG8_SA(b, h) (((b) * 2 + (h)) * HTB)
#define PG8_SB(b, h) ((4 + (b) * 2 + (h)) * HTB)
#define PG8_STAGE(bufoff, gbase, voff) do { _Pragma("unroll") for (int _i = 0; _i < 2; ++_i) \
        __builtin_amdgcn_global_load_lds((const unsigned*)((const char*)(gbase) + (voff)[_i]), (LAS unsigned*)(lds + (bufoff) + ldsw + _i * 8192), 16, 0, 0); } while (0)
#define PG8_LDA8(m_, slot_) cat_frag(*(const LAS bf16x8*)(lds + (slot_) + (m_) * 2048), *(const LAS bf16x8*)(lds + (slot_) + (m_) * 2048 + 1024))
#define PG8_LDA(dst, b, h) do { if constexpr (FP8) { a_slot = PG8_SA(b, h) + aoff; dst##8[0] = PG8_LDA8(0, a_slot); dst##8[1] = PG8_LDA8(1, a_slot); } \
        else { _Pragma("unroll") for (int m = 0; m < 4; ++m) _Pragma("unroll") for (int k = 0; k < 2; ++k) dst[m][k] = *(const LAS bf16x8*)(lds + PG8_SA(b, h) + aoff + m * 2048 + k * 1024); } } while (0)
#define PG8_LDB(dst, b, h) do { if constexpr (FP8) { _Pragma("unroll") for (int n = 0; n < 2; ++n) dst##8[n] = cat_frag(*(const LAS bf16x8*)(lds + PG8_SB(b, h) + boff + n * 2048), *(const LAS bf16x8*)(lds + PG8_SB(b, h) + boff + n * 2048 + 1024)); } \
        else { _Pragma("unroll") for (int n = 0; n < 2; ++n) _Pragma("unroll") for (int k = 0; k < 2; ++k) dst[n][k] = *(const LAS bf16x8*)(lds + PG8_SB(b, h) + boff + n * 2048 + k * 1024); } } while (0)
#define PG8_MMA(ai, bj, At, Bt) do { __builtin_amdgcn_s_setprio(1); \
        { _Pragma("unroll") for (int m = 0; m < 4; ++m) _Pragma("unroll") for (int n = 0; n < 2; ++n) _Pragma("unroll") for (int k = 0; k < 2; ++k) \
            acc[ai][bj][m][n] = __builtin_amdgcn_mfma_f32_16x16x32_bf16(Bt[n][k], At[m][k], acc[ai][bj][m][n], 0, 0, 0); } \
        __builtin_amdgcn_s_setprio(0); } while (0)
#define PG8_FMA8(accv, Bv, Av) asm volatile("v_mfma_scale_f32_16x16x128_f8f6f4 %0, %1, %2, %0, %3, %3 op_sel_hi:[0,0,0]" : "+v"(accv) : "v"(Bv), "v"(Av), "v"(one8))
#define PG8_MMA8(ai, mm, Ar) do { _Pragma("unroll") for (int n = 0; n < 2; ++n) PG8_FMA8(acc[ai][0][mm][n], B08[n], Ar); \
        _Pragma("unroll") for (int n = 0; n < 2; ++n) PG8_FMA8(acc[ai][1][mm][n], B18[n], Ar); } while (0)
#define PG8_MMAP(ai) do { if constexpr (FP8) { __builtin_amdgcn_s_setprio(1); PG8_MMA8(ai, 0, At8[0]); PG8_SCHED; At8[0] = PG8_LDA8(2, a_slot); PG8_SCHED; PG8_MMA8(ai, 1, At8[1]); PG8_SCHED; At8[1] = PG8_LDA8(3, a_slot); PG8_SCHED; \
            PG8_MMA8(ai, 2, At8[0]); PG8_MMA8(ai, 3, At8[1]); __builtin_amdgcn_s_setprio(0); } \
        else { PG8_MMA(ai, 0, At, B0); PG8_MMA(ai, 1, At, B1); } } while (0)
#define PG8_WAIT_V(n) asm volatile("s_waitcnt vmcnt(" #n ")" ::: "memory")
#define PG8_WAIT_L(n) asm volatile("s_waitcnt lgkmcnt(" #n ")" ::: "memory")
#define PG8_BAR __builtin_amdgcn_s_barrier()
#define PG8_SCHED __builtin_amdgcn_sched_barrier(0)
    Unit cur, nxt; int ui = 0;
    if (!S.next(0, cur)) return;
    f32x4 acc[2][2][4][2];
#pragma unroll
    for (int a = 0; a < 2; ++a)
#pragma unroll
        for (int b = 0; b < 2; ++b)
#pragma unroll
            for (int m = 0; m < 4; ++m)
#pragma unroll
                for (int n = 0; n < 2; ++n) acc[a][b][m][n] = (f32x4){0.f, 0.f, 0.f, 0.f};
    bf16x8 At[4][2], B0[2][2], B1[2][2];
    v8i_t At8[2], B08[2], B18[2]; int a_slot = 0; const int one8 = 0x7F7F7F7F;
    const char* cA = S.aptr(cur); const char* cB = S.bptr(cur); int nt = S.nt(cur);
    PG8_STAGE(PG8_SB(0, 0), cB, voffB); PG8_STAGE(PG8_SB(0, 1), cB + hstepB, voffB); PG8_STAGE(PG8_SA(0, 0), cA, voffA); PG8_STAGE(PG8_SA(0, 1), cA + hstepA, voffA);
    if (wr == 1) PG8_BAR;
    PG8_WAIT_V(2); PG8_BAR;
    PG8_STAGE(PG8_SB(1, 0), cB + kstep, voffB); PG8_STAGE(PG8_SA(1, 0), cA + kstep, voffA); PG8_STAGE(PG8_SB(1, 1), cB + hstepB + kstep, voffB);
    PG8_WAIT_V(6); PG8_BAR;
    for (;;) {
        const bool has_next = S.next(ui + 1, nxt);
        const char* nA = has_next ? S.aptr(nxt) : cA; const char* nB = has_next ? S.bptr(nxt) : cB;
        for (int t = 0; t < nt; t += 2) {
            const bool last = (t == nt - 2);
            const char* a1 = cA + (size_t)(t + 1) * kstep;
            const char* a2 = last ? nA : cA + (size_t)(t + 2) * kstep; const char* b2 = last ? nB : cB + (size_t)(t + 2) * kstep;
            const char* a3 = a2 + kstep; const char* b3 = b2 + kstep;
            PG8_LDB(B0, 0, 0); PG8_LDB(B1, 0, 1); PG8_SCHED; PG8_LDA(At, 0, 0); PG8_STAGE(PG8_SA(1, 1), a1 + hstepA, voffA);
            PG8_WAIT_V(8); PG8_WAIT_L(0); PG8_BAR; PG8_MMAP(0); PG8_BAR; PG8_SCHED;
            PG8_LDA(At, 0, 1); PG8_STAGE(PG8_SB(0, 0), b2, voffB); PG8_STAGE(PG8_SB(0, 1), b2 + hstepB, voffB); PG8_STAGE(PG8_SA(0, 0), a2, voffA);
            PG8_WAIT_V(8); PG8_WAIT_L(0); PG8_BAR; PG8_MMAP(1); PG8_BAR; PG8_SCHED;
            PG8_LDB(B0, 1, 0); PG8_LDB(B1, 1, 1); PG8_SCHED; PG8_LDA(At, 1, 0); PG8_STAGE(PG8_SA(0, 1), a2 + hstepA, voffA);
            PG8_WAIT_V(8); PG8_WAIT_L(0); PG8_BAR; PG8_MMAP(0); PG8_BAR; PG8_SCHED;
            PG8_LDA(At, 1, 1); PG8_STAGE(PG8_SB(1, 0), b3, voffB); PG8_STAGE(PG8_SB(1, 1), b3 + hstepB, voffB); PG8_STAGE(PG8_SA(1, 0), a3, voffA);
            PG8_WAIT_V(8); PG8_WAIT_L(0); PG8_BAR; PG8_MMAP(1); PG8_BAR; PG8_SCHED;
        }
        if (wr == 0) PG8_BAR;
        if constexpr (FP8) asm volatile("s_nop 15\n\ts_nop 15" ::: "memory");
        E(acc, cur, wr, wc, fr, fq);
        if (!has_next) break;
#pragma unroll
        for (int a = 0; a < 2; ++a)
#pragma unroll
            for (int b = 0; b < 2; ++b)
#pragma unroll
                for (int m = 0; m < 4; ++m)
#pragma unroll
                    for (int n = 0; n < 2; ++n) acc[a][b][m][n] = (f32x4){0.f, 0.f, 0.f, 0.f};
        cur = nxt; cA = nA; cB = nB; nt = S.nt(cur); ++ui;
        if (wr == 1) PG8_BAR;
    }
    PG8_WAIT_V(0);
    PG8_BAR;
#undef PG8_SA
#undef PG8_SB
#undef PG8_STAGE
#undef PG8_LDA
#undef PG8_LDB
#undef PG8_MMA
#undef PG8_MMA8
#undef PG8_FMA8
#undef PG8_MMAP
#undef PG8_LDA8
#undef PG8_WAIT_V
#undef PG8_WAIT_L
#undef PG8_BAR
#undef PG8_SCHED
}
}

struct Params {
    const float* x; const float* c; const float* ctx; const float* c_ctx; const float* ada_w; const float* ada_b;
    const float* norm1_g; const float* norm2_g; const float* final_g;
    const float* ret_w_in; const float* ret_decay_f; const float* ret_decay_b; const float* ret_gn_f; const float* ret_gn_b; const float* ret_w_out;
    const float* swa_w_qkv; const float* swa_sink; const float* swa_w_out;
    const float* moe_router; const float* moe_w_gate; const float* moe_w_up; const float* moe_w_down;
    float* out; unsigned char* ws;
    int ph_lo, ph_hi;
};
#define WSP(T_, off) ((T_*)(P.ws + (off)))

struct SchedIn {
    const bf16_t* H; const bf16_t* Wqkg; const bf16_t* Wv; int ng, x, kx;
    __device__ __forceinline__ bool next(int i, pg8::Unit& u) const {
        const int li = i * ng + kx; if (li >= 288) return false;
        if (li < 216) { const int mi = li % 9; u.pm = mi < 8 ? 8 * x + mi : 64 + x; u.pn = li / 9; u.aux = 0; }
        else { const int q = li - 216, ri = q >> 3; u.pm = q & 7; u.pn = ri < 8 ? 8 * x + ri : 64 + x; u.aux = 1; }
        return true;
    }
    __device__ __forceinline__ int nt(const pg8::Unit&) const { return 16; }
    __device__ __forceinline__ const char* aptr(const pg8::Unit& u) const { return (const char*)((u.aux ? Wv : H) + (size_t)u.pm * 256 * 1024); }
    __device__ __forceinline__ const char* bptr(const pg8::Unit& u) const { return (const char*)((u.aux ? H : Wqkg) + (size_t)u.pm * 0 + (size_t)u.pn * 256 * 1024); }
};
struct SchedPlain {
    const bf16_t* A; const bf16_t* B; int lda, ldb, nM, nN, G, c;
    __device__ __forceinline__ int nt(const pg8::Unit&) const { return lda >> 6; }
    __device__ __forceinline__ bool next(int i, pg8::Unit& u) const {
        const int L = i * G + c; if (L >= nM * nN) return false;
        pg8::tile_order(L, nM, nN, u.pm, u.pn); u.aux = -1; return true;
    }
    __device__ __forceinline__ const char* aptr(const pg8::Unit& u) const { return (const char*)(A + (size_t)u.pm * 256 * lda); }
    __device__ __forceinline__ const char* bptr(const pg8::Unit& u) const { return (const char*)(B + (size_t)u.pn * 256 * ldb); }
};
struct SchedQkv {
    const bf16_t* A; const bf16_t* B; int G, c;
    __device__ __forceinline__ int nt(const pg8::Unit&) const { return 8; }
    __device__ __forceinline__ bool next(int i, pg8::Unit& u) const {
        const int L = i * G + c; if (L >= 328) return false;
        if (L < 320) { pg8::tile_order(L, 64, 5, u.pm, u.pn); } else { u.pm = 64 + (L - 320); u.pn = 4; }
        u.aux = 0; return true;
    }
    __device__ __forceinline__ const char* aptr(const pg8::Unit& u) const { return (const char*)A + (size_t)u.pm * 256 * 1024; }
    __device__ __forceinline__ const char* bptr(const pg8::Unit& u) const { return (const char*)B + (size_t)u.pn * 256 * 1024; }
};
struct SchedGrouped {
    const bf16_t* A; const bf16_t* B; int lda, ldb, nMe, nNe, G, c;
    __device__ __forceinline__ int nt(const pg8::Unit&) const { return lda >> 6; }
    __device__ __forceinline__ bool next(int i, pg8::Unit& u) const {
        const int upe = nMe * nNe, spx = G >> 3, idx = i * spx + (c >> 3); if (idx >= 2 * upe) return false;
        const int e = (c & 7) + 8 * (idx / upe), r = idx % upe, gw = nNe < 8 ? nNe : 8;
        const int gcol = r / (nMe * gw), rr = r - gcol * nMe * gw, pml = rr / gw, pnl = gcol * gw + rr % gw;
        u.pm = e * nMe + pml; u.pn = e * nNe + pnl; u.aux = pnl; return true;
    }
    __device__ __forceinline__ const char* aptr(const pg8::Unit& u) const { return (const char*)(A + (size_t)u.pm * 256 * lda); }
    __device__ __forceinline__ const char* bptr(const pg8::Unit& u) const { return (const char*)(B + (size_t)u.pn * 256 * ldb); }
};

struct SchedRO {
    const bf16_t* A; const bf16_t* B; int G, c;
    __device__ __forceinline__ bool next(int i, pg8::Unit& u) const {
        const int L = i * G + c; if (L >= 384) return false;
        if (L < 256) { pg8::tile_order(L, 64, 4, u.pm, u.pn); u.aux = -1; } else { const int j = L - 256, r = j >> 3; u.pm = 64 + (j & 7); u.pn = r & 3; u.aux = r >> 2; }
        return true;
    }
    __device__ __forceinline__ int nt(const pg8::Unit& u) const { return u.aux < 0 ? 32 : 8; }
    __device__ __forceinline__ const char* aptr(const pg8::Unit& u) const { return (const char*)(A + (size_t)u.pm * 256 * 2048 + (u.aux < 0 ? 0 : u.aux * 512)); }
    __device__ __forceinline__ const char* bptr(const pg8::Unit& u) const { return (const char*)(B + (size_t)u.pn * 256 * 2048 + (u.aux < 0 ? 0 : u.aux * 512)); }
};
struct SchedDown0 {
    const bf16_t* A; const bf16_t* B; int G, c, ld;
    __device__ __forceinline__ bool next(int i, pg8::Unit& u) const {
        const int spx = G >> 3, idx = i * spx + (c >> 3); if (idx >= 96) return false;
        if (idx < 64) { const int e = (c & 7) + 8 * (idx >> 5), r = idx & 31; u.pm = e * 9 + (r >> 2); u.pn = e * 4 + (r & 3); u.aux = r & 3; }
        else { const int q = idx - 64, e = (c & 7) + 8 * (q >> 4), qq = q & 15, pnl = qq >> 2, sl = qq & 3; u.pm = e * 9 + 8; u.pn = e * 4 + pnl; u.aux = pnl + 4 * (sl + 1); }
        return true;
    }
    __device__ __forceinline__ int nt(const pg8::Unit& u) const { return u.aux < 4 ? (ld >> 6) : (ld >> 8); }
    __device__ __forceinline__ const char* aptr(const pg8::Unit& u) const { return (const char*)(A + (size_t)u.pm * 256 * ld + (u.aux < 4 ? 0 : ((u.aux >> 2) - 1) * (ld >> 2))); }
    __device__ __forceinline__ const char* bptr(const pg8::Unit& u) const { return (const char*)(B + (size_t)u.pn * 256 * ld + (u.aux < 4 ? 0 : ((u.aux >> 2) - 1) * (ld >> 2))); }
};

struct EpiIn {
    static constexpr bool PERM = true;
    bf16_t* QKG; bf16_t* VT;
    __device__ __forceinline__ void operator()(const f32x4 (&acc)[2][2][4][2], const pg8::Unit& u, int wr, int wc, int fr, int fq) const {
        bf16_t* base = u.aux ? VT : QKG; const size_t ld = u.aux ? (size_t)NROW : (size_t)QKG_LD;
        const int row0 = u.pm * 256 + wr * 64 + fr, col0 = u.pn * 256 + wc * 32 + 8 * fq;
#pragma unroll
        for (int ai = 0; ai < 2; ++ai)
#pragma unroll
            for (int m = 0; m < 4; ++m) { bf16_t* rowp = base + (size_t)(row0 + ai * 128 + m * 16) * ld + col0;
#pragma unroll
                for (int bj = 0; bj < 2; ++bj) { const f32x4 v0 = acc[ai][bj][m][0], v1 = acc[ai][bj][m][1];
                    u32x4 w; w.x = cvt_pk_bf16(v0[0], v0[1]); w.y = cvt_pk_bf16(v0[2], v0[3]); w.z = cvt_pk_bf16(v1[0], v1[1]); w.w = cvt_pk_bf16(v1[2], v1[3]);
                    *(u32x4*)(rowp + bj * 128) = w; } }
    }
};
struct EpiRes {
    static constexpr bool PERM = false;
    const float* rl; const float* rc; const bf16_t* rb; const float* gate; bf16_t* out; float* slab; float dsc;
    __device__ __forceinline__ void operator()(const f32x4 (&acc)[2][2][4][2], const pg8::Unit& u, int wr, int wc, int fr, int fq) const {
        const int rowt = u.pm * 256; const int ci = rowt < NLAT ? rowt / T : 8;
        const float* rbase = rowt < NLAT ? rl : rc - (size_t)NLAT * D;
        if (u.aux >= 0) {
            float* ob = slab + ((size_t)u.aux * NCTX - NLAT) * D;
            const int row0 = rowt + wr * 64 + fr, col0 = u.pn * 256 + wc * 32 + 4 * fq;
#pragma unroll
            for (int ai = 0; ai < 2; ++ai)
#pragma unroll
                for (int m = 0; m < 4; ++m) { const size_t off = (size_t)(row0 + ai * 128 + m * 16) * D + col0;
#pragma unroll
                    for (int bj = 0; bj < 2; ++bj)
#pragma unroll
                        for (int n = 0; n < 2; ++n) { const f32x4 gv = *(const f32x4*)(gate + (size_t)ci * 6144 + col0 + bj * 128 + n * 16);
                            f32x4 r = gv * acc[ai][bj][m][n]; if (u.aux == 0) r = r + *(const f32x4*)(rbase + off + bj * 128 + n * 16);
                            *(f32x4*)(ob + off + bj * 128 + n * 16) = r; }
                    asm volatile("" ::: "memory"); }
            return;
        }
        const int row0 = rowt + wr * 64 + fr, col0 = u.pn * 256 + wc * 32 + 4 * fq;
        f32x4 gv[2][2];
#pragma unroll
        for (int bj = 0; bj < 2; ++bj)
#pragma unroll
            for (int n = 0; n < 2; ++n) gv[bj][n] = *(const f32x4*)(gate + (size_t)ci * 6144 + col0 + bj * 128 + n * 16) * dsc;
        if (rb) {
            u32x2 rq[3][2][2];
#pragma unroll
            for (int g0 = 0; g0 < 2; ++g0) { const size_t off = (size_t)(row0 + (g0 >> 2) * 128 + (g0 & 3) * 16) * D + col0;
#pragma unroll
                for (int bj = 0; bj < 2; ++bj)
#pragma unroll
                    for (int n = 0; n < 2; ++n) rq[g0][bj][n] = *(const u32x2*)(rb + off + bj * 128 + n * 16); }
#pragma unroll
            for (int gi = 0; gi < 8; ++gi) { const int ai = gi >> 2, m = gi & 3; const size_t off = (size_t)(row0 + ai * 128 + m * 16) * D + col0;
                if (gi + 2 < 8) { const size_t off2 = (size_t)(row0 + ((gi + 2) >> 2) * 128 + ((gi + 2) & 3) * 16) * D + col0;
#pragma unroll
                    for (int bj = 0; bj < 2; ++bj)
#pragma unroll
                        for (int n = 0; n < 2; ++n) rq[(gi + 2) % 3][bj][n] = *(const u32x2*)(rb + off2 + bj * 128 + n * 16); }
#pragma unroll
                for (int bj = 0; bj < 2; ++bj)
#pragma unroll
                    for (int n = 0; n < 2; ++n) { const u32x2 w = rq[gi % 3][bj][n]; const f32x4 r = {bf_lo(w.x), bf_hi(w.x), bf_lo(w.y), bf_hi(w.y)};
                        const f32x4 o = r + gv[bj][n] * acc[ai][bj][m][n]; u32x2 wv; wv.x = cvt_pk_bf16(o[0], o[1]); wv.y = cvt_pk_bf16(o[2], o[3]);
                        *(u32x2*)(out + off + bj * 128 + n * 16) = wv; }
                __builtin_amdgcn_sched_barrier(0); }
        } else {
            f32x4 rq[3][2][2];
#pragma unroll
            for (int g0 = 0; g0 < 2; ++g0) { const size_t off = (size_t)(row0 + (g0 >> 2) * 128 + (g0 & 3) * 16) * D + col0;
#pragma unroll
                for (int bj = 0; bj < 2; ++bj)
#pragma unroll
                    for (int n = 0; n < 2; ++n) rq[g0][bj][n] = *(const f32x4*)(rbase + off + bj * 128 + n * 16); }
#pragma unroll
            for (int gi = 0; gi < 8; ++gi) { const int ai = gi >> 2, m = gi & 3; const size_t off = (size_t)(row0 + ai * 128 + m * 16) * D + col0;
                if (gi + 2 < 8) { const size_t off2 = (size_t)(row0 + ((gi + 2) >> 2) * 128 + ((gi + 2) & 3) * 16) * D + col0;
#pragma unroll
                    for (int bj = 0; bj < 2; ++bj)
#pragma unroll
                        for (int n = 0; n < 2; ++n) rq[(gi + 2) % 3][bj][n] = *(const f32x4*)(rbase + off2 + bj * 128 + n * 16); }
#pragma unroll
                for (int bj = 0; bj < 2; ++bj)
#pragma unroll
                    for (int n = 0; n < 2; ++n) { const f32x4 o = rq[gi % 3][bj][n] + gv[bj][n] * acc[ai][bj][m][n]; u32x2 wv; wv.x = cvt_pk_bf16(o[0], o[1]); wv.y = cvt_pk_bf16(o[2], o[3]);
                        *(u32x2*)(out + off + bj * 128 + n * 16) = wv; }
                __builtin_amdgcn_sched_barrier(0); }
        }
    }
};
struct EpiGU {
    static constexpr bool PERM = true;
    bf16_t* HID; int fp8;
    __device__ __forceinline__ void operator()(const f32x4 (&acc)[2][2][4][2], const pg8::Unit& u, int wr, int wc, int fr, int fq) const {
        const int row0 = u.pm * 256 + wr * 64 + fr, col0 = u.aux * 128 + wc * 32 + 8 * fq;
        if (fp8) {
            constexpr float dsc = 1.0f / (FP8_SX * FP8_SW);
#pragma unroll
            for (int ai = 0; ai < 2; ++ai)
#pragma unroll
                for (int m = 0; m < 4; ++m) {
                    f32x4 hq[2];
#pragma unroll
                    for (int n = 0; n < 2; ++n) { const f32x4 ga = acc[ai][0][m][n], t = ga * (-dsc * LOG2E), p = (ga * acc[ai][1][m][n]) * (dsc * dsc * FP8_SH); f32x4 r;
#pragma unroll
                        for (int e = 0; e < 4; ++e) r[e] = __builtin_amdgcn_rcpf(1.0f + __builtin_amdgcn_exp2f(t[e]));
                        hq[n] = p * r; }
                    u32x2 w; w.x = pk4_fp8(hq[0][0], hq[0][1], hq[0][2], hq[0][3]); w.y = pk4_fp8(hq[1][0], hq[1][1], hq[1][2], hq[1][3]);
                    *(u32x2*)((unsigned char*)HID + (size_t)(row0 + ai * 128 + m * 16) * FF + col0) = w; }
            return;
        }
#pragma unroll
        for (int ai = 0; ai < 2; ++ai)
#pragma unroll
            for (int m = 0; m < 4; ++m) {
                float h[8];
#pragma unroll
                for (int n = 0; n < 2; ++n)
#pragma unroll
                    for (int e = 0; e < 4; ++e) h[n * 4 + e] = silu_f(acc[ai][0][m][n][e]) * acc[ai][1][m][n][e];
                u32x4 w; w.x = cvt_pk_bf16(h[0], h[1]); w.y = cvt_pk_bf16(h[2], h[3]); w.z = cvt_pk_bf16(h[4], h[5]); w.w = cvt_pk_bf16(h[6], h[7]);
                *(u32x4*)(HID + (size_t)(row0 + ai * 128 + m * 16) * FF + col0) = w; }
    }
};
struct EpiDown {
    static constexpr bool PERM = true;
    bf16_t* YS; const float* GATE; bf16_t* YS2; float dsc;
    __device__ __forceinline__ void operator()(const f32x4 (&acc)[2][2][4][2], const pg8::Unit& u, int wr, int wc, int fr, int fq) const {
        const int row0 = u.pm * 256 + wr * 64 + fr, col0 = (u.aux & 3) * 256 + wc * 32 + 8 * fq;
        if (u.aux >= 8) {
            const int e = u.pm / 9, sl = (u.aux >> 2) - 1; bf16_t* ob = YS2 + ((size_t)(sl - 1) * 4096 + e * 256) * D;
#pragma unroll
            for (int ai = 0; ai < 2; ++ai)
#pragma unroll
                for (int m = 0; m < 4; ++m) { const int rl_ = wr * 64 + fr + ai * 128 + m * 16; const float gt = GATE[u.pm * 256 + rl_] * dsc;
#pragma unroll
                    for (int bj = 0; bj < 2; ++bj) { const f32x4 v0 = acc[ai][bj][m][0] * gt, v1 = acc[ai][bj][m][1] * gt;
                        u32x4 w; w.x = cvt_pk_bf16(v0[0], v0[1]); w.y = cvt_pk_bf16(v0[2], v0[3]); w.z = cvt_pk_bf16(v1[0], v1[1]); w.w = cvt_pk_bf16(v1[2], v1[3]);
                        *(u32x4*)(ob + (size_t)rl_ * D + col0 + bj * 128) = w; } }
            return;
        }
#pragma unroll
        for (int ai = 0; ai < 2; ++ai)
#pragma unroll
            for (int m = 0; m < 4; ++m) { const int row = row0 + ai * 128 + m * 16; const float gt = GATE[row] * (dsc * FP8_SO);
#pragma unroll
                for (int bj = 0; bj < 2; ++bj) { const f32x4 v0 = acc[ai][bj][m][0] * gt, v1 = acc[ai][bj][m][1] * gt;
                    u32x2 w; w.x = pk4_fp8(v0[0], v0[1], v0[2], v0[3]); w.y = pk4_fp8(v1[0], v1[1], v1[2], v1[3]);
                    *(u32x2*)((unsigned char*)YS + (size_t)row * D + col0 + bj * 128) = w; } }
    }
};
struct EpiQkv {
    static constexpr bool PERM = true;
    bf16_t* O; const float* rope; float dsc;
    __device__ __forceinline__ void operator()(const f32x4 (&acc)[2][2][4][2], const pg8::Unit& u, int wr, int wc, int fr, int fq) const {
        const int rowt = u.pm * 256; const bool lat = rowt < NLAT;
        const int row0 = rowt + wr * 64 + fr, col0 = u.pn * 256 + wc * 32 + 8 * fq;
#pragma unroll
        for (int ai = 0; ai < 2; ++ai)
#pragma unroll
            for (int m = 0; m < 4; ++m) { const int row = row0 + ai * 128 + m * 16; const int t = row & (T - 1);
                const int pos = (wc & 1) ? (t & 63) : (t >> 6);
                const f32x4 cs0 = *(const f32x4*)(rope + (size_t)(pos * 16 + 4 * fq) * 2), cs1 = *(const f32x4*)(rope + (size_t)(pos * 16 + 4 * fq) * 2 + 4);
                const float cc[4] = {cs0[0], cs0[2], cs1[0], cs1[2]}, ss[4] = {cs0[1], cs0[3], cs1[1], cs1[3]};
#pragma unroll
                for (int bj = 0; bj < 2; ++bj) { f32x4 v0 = acc[ai][bj][m][0] * dsc, v1 = acc[ai][bj][m][1] * dsc;
                    const bool dorope = lat && (u.pn < 4 || bj == 0);
                    if (dorope) {
#pragma unroll
                        for (int e = 0; e < 4; ++e) { const float a = v0[e], b = v1[e]; v0[e] = a * cc[e] - b * ss[e]; v1[e] = b * cc[e] + a * ss[e]; } }
                    u32x4 w; w.x = cvt_pk_bf16(v0[0], v0[1]); w.y = cvt_pk_bf16(v0[2], v0[3]); w.z = cvt_pk_bf16(v1[0], v1[1]); w.w = cvt_pk_bf16(v1[2], v1[3]);
                    *(u32x4*)(O + (size_t)row * QKV_LD + col0 + bj * 128) = w; } }
    }
};

__device__ __forceinline__ int rope_perm(int s) { return s < 16 ? ((s >> 2) * 8 + (s & 3)) : (((s - 16) >> 2) * 8 + 4 + (s & 3)); }
__device__ __forceinline__ void transpose_item(const float* W, int ldw, int k0, int n0, bf16_t* WT, int ldt, int drow0, bool rperm, float scale, LAS float* scr, int lane) {
#pragma unroll 8
    for (int i = 0; i < 32; ++i) { const int kk = 2 * i + (lane >> 5); scr[kk * 33 + (lane & 31)] = W[(size_t)(k0 + kk) * ldw + n0 + (lane & 31)]; }
    asm volatile("s_waitcnt lgkmcnt(0)" ::: "memory");
    const int c = lane & 7;
#pragma unroll
    for (int j = 0; j < 4; ++j) { const int n = (lane >> 3) + 8 * j; const LAS float* s = scr + (8 * c) * 33 + n;
        u32x4 o; o.x = cvt_pk_bf16(s[0 * 33] * scale, s[1 * 33] * scale); o.y = cvt_pk_bf16(s[2 * 33] * scale, s[3 * 33] * scale);
        o.z = cvt_pk_bf16(s[4 * 33] * scale, s[5 * 33] * scale); o.w = cvt_pk_bf16(s[6 * 33] * scale, s[7 * 33] * scale);
        const int dn = rperm ? rope_perm(n) : n;
        *(u32x4*)(WT + (size_t)(drow0 + dn) * ldt + k0 + 8 * c) = o; }
    asm volatile("s_waitcnt lgkmcnt(0)" ::: "memory");
}
__device__ __forceinline__ void transpose_item_fp8(const float* W, int ldw, int k0, int n0, unsigned char* WT, int ldt, int drow0, bool rperm, float scale, LAS float* scr, int lane) {
#pragma unroll 8
    for (int i = 0; i < 32; ++i) { const int kk = 2 * i + (lane >> 5); scr[kk * 33 + (lane & 31)] = W[(size_t)(k0 + kk) * ldw + n0 + (lane & 31)]; }
    asm volatile("s_waitcnt lgkmcnt(0)" ::: "memory");
    const int c = lane & 7;
#pragma unroll
    for (int j = 0; j < 4; ++j) { const int n = (lane >> 3) + 8 * j; const LAS float* sp = scr + (8 * c) * 33 + n;
        u32x2 o; o.x = pk4_fp8(sp[0 * 33] * scale, sp[1 * 33] * scale, sp[2 * 33] * scale, sp[3 * 33] * scale); o.y = pk4_fp8(sp[4 * 33] * scale, sp[5 * 33] * scale, sp[6 * 33] * scale, sp[7 * 33] * scale);
        *(u32x2*)(WT + (size_t)(drow0 + (rperm ? rope_perm(n) : n)) * ldt + k0 + 8 * c) = o; }
    asm volatile("s_waitcnt lgkmcnt(0)" ::: "memory");
}
__device__ __forceinline__ void transpose_item_fp8_k128(const float* W, int ldw, int k0, int n0, unsigned char* WT, int ldt, int drow0, float scale, LAS float* scr, int lane) {
    float v[64];
    const float* p = W + (size_t)(k0 + (lane >> 5)) * ldw + n0 + (lane & 31);
#pragma unroll
    for (int i = 0; i < 64; ++i) v[i] = p[(size_t)(2 * i) * ldw];
#pragma unroll
    for (int i = 0; i < 64; ++i) scr[(2 * i + (lane >> 5)) * 33 + (lane & 31)] = v[i];
    asm volatile("s_waitcnt lgkmcnt(0)" ::: "memory");
    const int c = lane & 7;
#pragma unroll
    for (int j = 0; j < 4; ++j) { const int n = (lane >> 3) + 8 * j; const LAS float* sp = scr + (16 * c) * 33 + n;
        u32x4 o;
        o.x = pk4_fp8(sp[0 * 33] * scale, sp[1 * 33] * scale, sp[2 * 33] * scale, sp[3 * 33] * scale); o.y = pk4_fp8(sp[4 * 33] * scale, sp[5 * 33] * scale, sp[6 * 33] * scale, sp[7 * 33] * scale);
        o.z = pk4_fp8(sp[8 * 33] * scale, sp[9 * 33] * scale, sp[10 * 33] * scale, sp[11 * 33] * scale); o.w = pk4_fp8(sp[12 * 33] * scale, sp[13 * 33] * scale, sp[14 * 33] * scale, sp[15 * 33] * scale);
        *(u32x4*)(WT + (size_t)(drow0 + n) * ldt + k0 + 16 * c) = o; }
    asm volatile("s_waitcnt lgkmcnt(0)" ::: "memory");
}
__device__ __forceinline__ void phase_prologue(const Params& P, LAS unsigned char* lds, int vcu, int G) {
    const int tid = threadIdx.x, lane = tid & 63, wave = __builtin_amdgcn_readfirstlane(tid >> 6);
    float* MOD = WSP(float, WS_MOD);
    if ((int)blockIdx.x < 192) {
        LAS float* s = (LAS float*)lds; LAS float* red = (LAS float*)(lds + 36864);
        for (int idx = tid; idx < 9 * 1024; idx += 512) { const int ci = idx >> 10, k = idx & 1023; const float v = ci < 8 ? P.c[ci * 1024 + k] : P.c_ctx[k]; s[idx] = v / (1.0f + expf(-v)); }
        __syncthreads();
        for (int it = blockIdx.x; it < 192; it += G) {
            const int l = it / 96, n0 = (it % 96) * 64;
            float acc[9];
#pragma unroll
            for (int ci = 0; ci < 9; ++ci) acc[ci] = 0.f;
            const float* w = P.ada_w + (size_t)l * 1024 * 6144 + n0 + lane;
#pragma unroll 4
            for (int k = wave * 128; k < wave * 128 + 128; ++k) { const float wv = w[(size_t)k * 6144];
#pragma unroll
                for (int ci = 0; ci < 9; ++ci) acc[ci] += s[ci * 1024 + k] * wv; }
#pragma unroll
            for (int ci = 0; ci < 9; ++ci) red[(wave * 9 + ci) * 64 + lane] = acc[ci];
            __syncthreads();
            for (int idx = tid; idx < 576; idx += 512) { const int ci = idx >> 6, col = idx & 63; float sum = P.ada_b[l * 6144 + n0 + col];
#pragma unroll
                for (int ks = 0; ks < 8; ++ks) sum += red[(ks * 9 + ci) * 64 + col];
                MOD[(size_t)(l * 9 + ci) * 6144 + n0 + col] = sum; }
            __syncthreads();
        }
    }
    if ((int)blockIdx.x == G - 1) {
        float* R = WSP(float, WS_ROPE);
        for (int idx = tid; idx < 1024; idx += 512) { const int pos = idx >> 4, j = idx & 15; const float inv = powf(10000.0f, -(float)j / 16.0f); const float ang = (float)pos * inv;
            R[idx * 2] = cosf(ang); R[idx * 2 + 1] = sinf(ang); }
    }
    __syncthreads();
    LAS float* scr = (LAS float*)(lds + wave * 16896);
    const int gw = vcu * 8 + wave, NGW = G * 8;
    constexpr int I0 = 4096, I1 = 1024, I2 = 640, I3 = 512;
    constexpr int NITEMS = I0 + I1 + I2 + I3;
    for (int it = gw; it < NITEMS; it += NGW) {
        int r = it;
        if (r < I0) { const int kb = r >> 8, nb = r & 255, n0 = nb * 32;
            if (n0 < 2048) transpose_item(P.ret_w_in, 8192, kb * 64, n0, WSP(bf16_t, WS_WQKG), 1024, n0, false, n0 < 1024 ? 0.0625f : 1.0f, scr, lane);
            else if (n0 < 4096) transpose_item(P.ret_w_in, 8192, kb * 64, n0, WSP(bf16_t, WS_WV), 1024, n0 - 2048, false, 1.0f, scr, lane);
            else transpose_item(P.ret_w_in, 8192, kb * 64, n0, WSP(bf16_t, WS_WQKG), 1024, n0 - 2048, false, 1.0f, scr, lane);
            continue; } r -= I0;
        if (r < I1) { const int kb = r >> 5, nb = r & 31; transpose_item(P.ret_w_out, 1024, kb * 64, nb * 32, WSP(bf16_t, WS_WRO), 2048, nb * 32, false, 1.0f, scr, lane); continue; } r -= I1;
        if (r < I2) { const int kb = r / 40, nb = r % 40, n0 = nb * 32;
            transpose_item_fp8(P.swa_w_qkv, 1280, kb * 64, n0, WSP(unsigned char, WS_WQKV), 1024, n0, n0 < 1152, (n0 < 1024 ? 0.125f : 1.0f) * FP8_SW, scr, lane); continue; } r -= I2;
        { const int kb = r >> 5, nb = r & 31; transpose_item_fp8(P.swa_w_out, 1024, kb * 64, nb * 32, WSP(unsigned char, WS_WSO), 1024, nb * 32, false, FP8_SW, scr, lane); }
    }
}
constexpr int MOE_I4 = 16384;
#ifndef CONV_PX
#define CONV_PX 8
#endif
constexpr int MOE_NSUP = 3 * 32 * 128;
struct MoeItem { const float* src; unsigned char* dst; int ldw, ldt; };
__device__ __forceinline__ MoeItem moe_item(const Params& P, int r) {
    MoeItem m;
    if (r < 2 * 4096) { const int up = r >= 4096; if (up) r -= 4096; const int le = r >> 7, q = r & 127, kb = q >> 4, nb = q & 15;
        m.src = (up ? P.moe_w_up : P.moe_w_gate) + (size_t)le * 1024 * 2048 + (size_t)(kb * 128) * 2048 + nb * 128; m.ldw = 2048;
        m.dst = WSP(unsigned char, WS_GU) + (size_t)le * 4096 * 1024 + (size_t)(nb * 256 + (up ? 128 : 0)) * 1024 + kb * 128; m.ldt = 1024;
    } else { r -= 2 * 4096; const int le = r >> 7, q = r & 127, kb = q >> 3, nb = q & 7;
        m.src = P.moe_w_down + (size_t)le * 2048 * 1024 + (size_t)(kb * 128) * 1024 + nb * 128; m.ldw = 1024;
        m.dst = WSP(unsigned char, WS_DW) + (size_t)le * 1024 * 2048 + (size_t)(nb * 128) * 2048 + kb * 128; m.ldt = 2048; }
    return m;
}
__device__ __forceinline__ void moe_load(const MoeItem& m, int sb, int lane, f32x4 (&v)[16]) {
    const float* p = m.src + (size_t)(32 * sb + (lane >> 5)) * m.ldw + 4 * (lane & 31);
#pragma unroll
    for (int i = 0; i < 16; ++i) v[i] = __builtin_nontemporal_load((const f32x4*)(p + (size_t)(2 * i) * m.ldw));
}
__device__ __forceinline__ void moe_pack(int sb, int lane, const f32x4 (&v)[16], LAS unsigned* scr) {
    LAS unsigned* w = scr + (lane & 31) * 132 + 32 * sb + (sb >= 2 ? 4 : 0) + (lane >> 5);
#pragma unroll
    for (int i = 0; i < 16; ++i) w[2 * i] = pk4_fp8(v[i][0] * FP8_SW, v[i][1] * FP8_SW, v[i][2] * FP8_SW, v[i][3] * FP8_SW);
}
__device__ __forceinline__ void tr4x4_bytes(unsigned r0, unsigned r1, unsigned r2, unsigned r3, unsigned& o0, unsigned& o1, unsigned& o2, unsigned& o3) {
    const unsigned t01l = __builtin_amdgcn_perm(r1, r0, 0x05010400u), t01h = __builtin_amdgcn_perm(r1, r0, 0x07030602u);
    const unsigned t23l = __builtin_amdgcn_perm(r3, r2, 0x05010400u), t23h = __builtin_amdgcn_perm(r3, r2, 0x07030602u);
    o0 = __builtin_amdgcn_perm(t23l, t01l, 0x05040100u); o1 = __builtin_amdgcn_perm(t23l, t01l, 0x07060302u);
    o2 = __builtin_amdgcn_perm(t23h, t01h, 0x05040100u); o3 = __builtin_amdgcn_perm(t23h, t01h, 0x07060302u);
}
__device__ __forceinline__ void moe_flush(const MoeItem& m, int lane, LAS unsigned* scr) {
    asm volatile("s_waitcnt lgkmcnt(0)" ::: "memory");
    const int c = lane & 7, gq = lane >> 3;
#pragma unroll
    for (int pass = 0; pass < 4; ++pass) { const int g = gq + 8 * pass;
        const LAS unsigned* rd = scr + g * 132 + 16 * c + 4 * (c >> 2);
        u32x4 R[4], O[4];
#pragma unroll
        for (int q = 0; q < 4; ++q) R[q] = *(const LAS u32x4*)(rd + 4 * q);
#pragma unroll
        for (int q = 0; q < 4; ++q) { unsigned o0, o1, o2, o3; tr4x4_bytes(R[q].x, R[q].y, R[q].z, R[q].w, o0, o1, o2, o3); O[0][q] = o0; O[1][q] = o1; O[2][q] = o2; O[3][q] = o3; }
#pragma unroll
        for (int j = 0; j < 4; ++j) __builtin_nontemporal_store(O[j], (u32x4*)(m.dst + (size_t)(4 * g + j) * m.ldt + 16 * c));
    }
    asm volatile("s_waitcnt lgkmcnt(0)" ::: "memory");
}
__device__ __forceinline__ unsigned moe_grab_issue(unsigned* ctr, int lane) {
    unsigned base = 0, z = 0;
    asm volatile("" : "+v"(z));
    if (lane == 0) base = __hip_atomic_fetch_add(ctr + z, 1u, __ATOMIC_RELAXED, __HIP_MEMORY_SCOPE_AGENT);
    return base;
}
__device__ __forceinline__ int moe_grab_resolve(unsigned pend) { const unsigned base = __builtin_amdgcn_readfirstlane(pend); return base >= (unsigned)MOE_NSUP ? -1 : (int)base; }
__device__ __forceinline__ MoeItem moe_item_or_dummy(const Params& P, int r) {
    MoeItem m = moe_item(P, r < 0 ? 0 : r);
    if (r < 0) { m.src = P.moe_w_gate; m.ldw = 0; }
    return m;
}
__device__ __forceinline__ void moe_convert_pool(const Params& P, LAS unsigned char* lds, unsigned* ctr) {
    const int tid = threadIdx.x, lane = tid & 63, wave = __builtin_amdgcn_readfirstlane(tid >> 6);
    LAS unsigned* scr = (LAS unsigned*)(lds + wave * 16896);
    int cur = moe_grab_resolve(moe_grab_issue(ctr, lane));
    if (cur < 0) return;
    f32x4 va[16], vb[16];
    MoeItem m = moe_item(P, cur), mn;
    moe_load(m, 0, lane, va);
    for (;;) {
        const unsigned pend = moe_grab_issue(ctr, lane);
        moe_load(m, 1, lane, vb); moe_pack(0, lane, va, scr);
        moe_load(m, 2, lane, va); moe_pack(1, lane, vb, scr);
        moe_load(m, 3, lane, vb); moe_pack(2, lane, va, scr);
        const int nxt = moe_grab_resolve(pend);
        mn = moe_item_or_dummy(P, nxt); moe_load(mn, 0, lane, va); moe_pack(3, lane, vb, scr);
        moe_flush(m, lane, scr);
        if (nxt < 0) break;
        m = mn;
    }
}

__device__ __forceinline__ void row_load(const float* src, int lane, f32x4 (&v)[4]) {
#pragma unroll
    for (int j = 0; j < 4; ++j) v[j] = *(const f32x4*)(src + 4 * lane + 256 * j);
}
__device__ __forceinline__ void row_load_bf16(const bf16_t* src, int lane, f32x4 (&v)[4]) {
#pragma unroll
    for (int j = 0; j < 4; ++j) { const u32x2 w = *(const u32x2*)(src + 4 * lane + 256 * j); v[j] = (f32x4){bf_lo(w.x), bf_hi(w.x), bf_lo(w.y), bf_hi(w.y)}; }
}
__device__ __forceinline__ float row_rstd(const f32x4 (&v)[4]) {
    float ss = 0.f;
#pragma unroll
    for (int j = 0; j < 4; ++j) ss += (v[j][0] * v[j][0] + v[j][1] * v[j][1]) + (v[j][2] * v[j][2] + v[j][3] * v[j][3]);
    ss = wave_sum(ss);
    return 1.0f / sqrtf(ss * (1.0f / 1024.0f) + 1e-6f);
}
__device__ __forceinline__ void row_modulate(const f32x4 (&v)[4], float rstd, const float* g, const float* sh, const float* sc, int lane, f32x4 (&h)[4]) {
#pragma unroll
    for (int j = 0; j < 4; ++j) { const int c = 4 * lane + 256 * j; const f32x4 gg = *(const f32x4*)(g + c), s1 = *(const f32x4*)(sc + c), s0 = *(const f32x4*)(sh + c);
        h[j] = (v[j] * rstd * gg) * (s1 + 1.0f) + s0; }
}
__device__ __forceinline__ void row_store_bf16(bf16_t* dst, int lane, const f32x4 (&h)[4]) {
#pragma unroll
    for (int j = 0; j < 4; ++j) { u32x2 w; w.x = cvt_pk_bf16(h[j][0], h[j][1]); w.y = cvt_pk_bf16(h[j][2], h[j][3]); *(u32x2*)(dst + 4 * lane + 256 * j) = w; }
}
__device__ __forceinline__ const float* row_src0(const Params& P, int row) { return row < NLAT ? P.x + (size_t)row * D : P.ctx + (size_t)(row - NLAT) * D; }
__device__ __forceinline__ int row_cond(int row) { return row < NLAT ? row / T : 8; }
__device__ __forceinline__ int grp_row(int i, int wave) { const int x = blockIdx.x & 7, k = blockIdx.x >> 3; return i < 8 ? 2048 * x + 64 * k + 8 * i + wave : NLAT + 256 * x + 8 * k + wave; }

__device__ __forceinline__ void phase_norm1_l0(const Params& P, int vcu, int G) {
    const int lane = threadIdx.x & 63, wave = __builtin_amdgcn_readfirstlane(threadIdx.x >> 6);
    const float* MOD = WSP(float, WS_MOD); bf16_t* H = WSP(bf16_t, WS_HBUF);
    for (int ri = 0; ri < 9; ++ri) { const int row = grp_row(ri, wave);
        f32x4 v[4], h[4]; row_load(row_src0(P, row), lane, v);
        const float rstd = row_rstd(v); const float* m = MOD + (size_t)row_cond(row) * 6144;
        row_modulate(v, rstd, P.norm1_g, m, m + 1024, lane, h);
        row_store_bf16(H + (size_t)row * D, lane, h);
    }
}
template <bool CTX>
__device__ __forceinline__ void phase_norm2_router(const Params& P, LAS unsigned char* lds, int l, int nrows, int G) {
    const int tid = threadIdx.x, lane = tid & 63, wave = __builtin_amdgcn_readfirstlane(tid >> 6);
    const float* MODL = WSP(float, WS_MOD) + (size_t)l * 9 * 6144; unsigned char* H8 = WSP(unsigned char, WS_H2); bf16_t* XR = WSP(bf16_t, WS_XR);
    float* AFFL = WSP(float, WS_AFF); float* AFFC = AFFL + NB * NE * T;
    LAS u32x4* WHf = (LAS u32x4*)lds; LAS u32x4* WLf = (LAS u32x4*)(lds + 32768);
    LAS float* A1 = (LAS float*)(lds + 65536 + wave * 8192); LAS float* A0 = A1 + 1024;
    const int rl = lane & 15, kg = lane >> 4, gx = (int)blockIdx.x & 7, gk = (int)blockIdx.x >> 3;
    const bool ctx = CTX && wave == 4 && gk < 16, have = wave < 4 || ctx;
    const int t = ctx ? 1024 + 16 * gx + gk : 128 * gx + 4 * gk + (wave & 3);
    const int row = 16 * t + rl;
    LAS unsigned char* rowbuf = lds + 106496;
    volatile LAS unsigned* rdy = (volatile LAS unsigned*)(lds + 106496 + 16 * 2064);
    if (CTX && tid == 0) *rdy = 0u;
    u32x4 raw[32];
    if (have && !ctx) {
#pragma unroll
        for (int kk = 0; kk < 32; ++kk) raw[kk] = *(const u32x4*)(XR + (size_t)row * D + 32 * kk + 8 * kg);
    }
#pragma unroll 1
    for (int pi = 0; pi < 4; ++pi) {
        const int p = tid + 512 * pi, pkk = p >> 6, pkg = (p >> 4) & 3, e = p & 15;
        const float* src = P.moe_router + (size_t)l * 16384 + (size_t)(32 * pkk + 8 * pkg) * 16 + e;
        float w[8];
#pragma unroll
        for (int i = 0; i < 8; ++i) w[i] = src[16 * i];
        u32x4 hi, lo;
#pragma unroll
        for (int i = 0; i < 4; ++i) { const unsigned hw = cvt_pk_bf16(w[2 * i], w[2 * i + 1]); hi[i] = hw; lo[i] = cvt_pk_bf16(w[2 * i] - bf_lo(hw), w[2 * i + 1] - bf_hi(hw)); }
        WHf[p] = hi; WLf[p] = lo;
    }
    __syncthreads();
    if (CTX) {
        const int t4 = 1024 + 16 * gx + gk;
        if (wave >= 4 && gk < 16) {
            const int q = wave - 4;
#pragma unroll
            for (int half = 0; half < 2; ++half) {
#pragma unroll
                for (int u = 0; u < 2; ++u) {
                    const int r = 4 * q + 2 * half + u; const size_t grow = (size_t)16 * t4 + r;
                    const float* sp = WSP(float, R_XRP) + (grow - NLAT) * D; f32x4 v[4], t1[4], t2[4], t3[4];
                    row_load(sp, lane, v); row_load(sp + (size_t)NCTX * D, lane, t1); row_load(sp + (size_t)2 * NCTX * D, lane, t2); row_load(sp + (size_t)3 * NCTX * D, lane, t3);
#pragma unroll
                    for (int j = 0; j < 4; ++j) { const f32x4 x = (v[j] + t1[j]) + (t2[j] + t3[j]); u32x2 w; w.x = cvt_pk_bf16(x[0], x[1]); w.y = cvt_pk_bf16(x[2], x[3]);
                        *(u32x2*)(XR + grow * D + 4 * lane + 256 * j) = w; *(LAS u32x2*)(rowbuf + r * 2064 + (4 * lane + 256 * j) * 2) = w; }
                }
                __builtin_amdgcn_sched_barrier(0);
            }
            asm volatile("s_waitcnt lgkmcnt(0)" ::: "memory");
            if (lane == 0) __hip_atomic_fetch_add((LAS unsigned*)rdy, 1u, __ATOMIC_RELAXED, __HIP_MEMORY_SCOPE_WORKGROUP);
        }
    }
    if (!have) return;
    if (ctx) {
        while (*rdy < 4u) __builtin_amdgcn_s_sleep(1);
        asm volatile("" ::: "memory");
#pragma unroll
        for (int kk = 0; kk < 32; ++kk) raw[kk] = *(const LAS u32x4*)(rowbuf + rl * 2064 + 64 * kk + 16 * kg);
    }
    {
        const int cond = ctx ? 8 : (16 * t) / T; const float* g = P.norm2_g + l * 1024; const float* sh = MODL + (size_t)cond * 6144 + 3072; const float* sc = sh + 1024;
#pragma unroll
        for (int j = 0; j < 4; ++j) { const int c = 4 * lane + 256 * j; const f32x4 gg = *(const f32x4*)(g + c), s1 = *(const f32x4*)(sc + c), s0 = *(const f32x4*)(sh + c);
            *(LAS f32x4*)(A1 + c) = gg * (s1 + 1.0f); *(LAS f32x4*)(A0 + c) = s0; }
    }
    float ss = 0.f;
#pragma unroll
    for (int kk = 0; kk < 32; ++kk) {
#pragma unroll
        for (int i = 0; i < 4; ++i) { const float x0 = bf_lo(raw[kk][i]), x1 = bf_hi(raw[kk][i]); ss += x0 * x0 + x1 * x1; } }
    ss = sum_x16x32(ss);
    const float rstd = 1.0f / sqrtf(ss * (1.0f / 1024.0f) + 1e-6f);
#pragma unroll
    for (int kk = 0; kk < 32; ++kk) { asm volatile("" : "+v"(raw[kk]));  }
    asm volatile("s_waitcnt lgkmcnt(0)" ::: "memory");
    f32x4 accA = {0.f, 0.f, 0.f, 0.f}, accB = {0.f, 0.f, 0.f, 0.f};
    const LAS float* a1p = A1 + 8 * kg; const LAS float* a0p = A0 + 8 * kg;
    unsigned char* hrow = H8 + (size_t)row * D + 8 * kg;
#pragma unroll
    for (int kk = 0; kk < 32; ++kk) {
        const f32x4 m0 = *(const LAS f32x4*)(a1p + 32 * kk), m1 = *(const LAS f32x4*)(a1p + 32 * kk + 4), d0 = *(const LAS f32x4*)(a0p + 32 * kk), d1 = *(const LAS f32x4*)(a0p + 32 * kk + 4);
        const u32x4 bh = WHf[kk * 64 + lane], bl = WLf[kk * 64 + lane];
        float hv[8];
#pragma unroll
        for (int i = 0; i < 4; ++i) { const float x0 = bf_lo(raw[kk][i]) * rstd, x1 = bf_hi(raw[kk][i]) * rstd;
            const float mm0 = i < 2 ? m0[2 * i] : m1[2 * i - 4], mm1 = i < 2 ? m0[2 * i + 1] : m1[2 * i - 3], dd0 = i < 2 ? d0[2 * i] : d1[2 * i - 4], dd1 = i < 2 ? d0[2 * i + 1] : d1[2 * i - 3];
            hv[2 * i] = x0 * mm0 + dd0; hv[2 * i + 1] = x1 * mm1 + dd1; }
        u32x2 f8; f8.x = pk4_fp8(hv[0] * FP8_SX, hv[1] * FP8_SX, hv[2] * FP8_SX, hv[3] * FP8_SX); f8.y = pk4_fp8(hv[4] * FP8_SX, hv[5] * FP8_SX, hv[6] * FP8_SX, hv[7] * FP8_SX);
        *(u32x2*)(hrow + 32 * kk) = f8;
        u32x4 ah, al;
#pragma unroll
        for (int i = 0; i < 4; ++i) { const unsigned hw = cvt_pk_bf16(hv[2 * i], hv[2 * i + 1]); ah[i] = hw; al[i] = cvt_pk_bf16(hv[2 * i] - bf_lo(hw), hv[2 * i + 1] - bf_hi(hw)); }
        accA = __builtin_amdgcn_mfma_f32_16x16x32_bf16(__builtin_bit_cast(bf16x8, bh), __builtin_bit_cast(bf16x8, ah), accA, 0, 0, 0);
        accB = __builtin_amdgcn_mfma_f32_16x16x32_bf16(__builtin_bit_cast(bf16x8, bl), __builtin_bit_cast(bf16x8, ah), accB, 0, 0, 0);
        accB = __builtin_amdgcn_mfma_f32_16x16x32_bf16(__builtin_bit_cast(bf16x8, bh), __builtin_bit_cast(bf16x8, al), accB, 0, 0, 0);
        if (kk & 1) __builtin_amdgcn_sched_barrier(0);
    }
    const f32x4 lg = accA + accB;
    float mx = max_x16x32(fmaxf(fmaxf(lg[0], lg[1]), fmaxf(lg[2], lg[3])));
    f32x4 ex;
#pragma unroll
    for (int i = 0; i < 4; ++i) ex[i] = expf(lg[i] - mx);
    const float sum = sum_x16x32((ex[0] + ex[1]) + (ex[2] + ex[3]));
    const float inv = 1.0f / sum;
    if (!ctx) { const int b = row / T, tt = row % T;
#pragma unroll
        for (int i = 0; i < 4; ++i) AFFL[(size_t)(b * 16 + 4 * kg + i) * T + tt] = ex[i] * inv; }
    else { const int r2 = row - NLAT, b = r2 / TC, tt = r2 % TC;
#pragma unroll
        for (int i = 0; i < 4; ++i) AFFC[(size_t)(b * 16 + 4 * kg + i) * TC + tt] = ex[i] * inv; }
}
__device__ __forceinline__ void phase_topk(const Params& P, LAS unsigned char* lds, int l, int G) {
    const int tid = threadIdx.x, lane = tid & 63, wave = __builtin_amdgcn_readfirstlane(tid >> 6);
    const float* AFFL = WSP(float, WS_AFF); const float* AFFC = AFFL + NB * NE * T;
    int* TOK = WSP(int, WS_TOK); float* GATE = WSP(float, WS_GATE); int* INV = WSP(int, WS_INV);
    LAS unsigned* cnt = (LAS unsigned*)lds;
    LAS int* sel = (LAS int*)(lds + 256);
    const int nitems = l == 0 ? 256 : 128, rows_per_e = l == 0 ? 2304 : 2048;
    for (int it = blockIdx.x; it < nitems; it += G) {
        const bool isctx = it >= 128; const int be = it & 127, b = be >> 4, e = be & 15;
        const int n = isctx ? TC : T; const unsigned cap = isctx ? 32u : 256u;
        const float* a = isctx ? AFFC + (size_t)be * TC : AFFL + (size_t)be * T;
        float av[4] = {0.f, 0.f, 0.f, 0.f}; unsigned key[4] = {0u, 0u, 0u, 0u};
        if (tid * 4 < n) { const f32x4 v = *(const f32x4*)(a + tid * 4);
#pragma unroll
            for (int k = 0; k < 4; ++k) { av[k] = v[k]; key[k] = __float_as_uint(v[k]); } }
        unsigned thr = 0u; int par = 0;
        for (int bit = 30; bit >= 0; --bit) {
            const unsigned cand = thr | (1u << bit); unsigned c = 0u;
#pragma unroll
            for (int k = 0; k < 4; ++k) c += (unsigned)__popcll(__ballot(key[k] >= cand));
            if (lane == 0) cnt[par * 8 + wave] = c;
            __syncthreads();
            unsigned tot = 0u;
#pragma unroll
            for (int w2 = 0; w2 < 8; ++w2) tot += cnt[par * 8 + w2];
            if (tot >= cap) thr = cand;
            par ^= 1;
        }
        unsigned packed = 0u;
#pragma unroll
        for (int k = 0; k < 4; ++k) packed += (key[k] > thr ? 1u : 0u) + (key[k] == thr ? 0x10000u : 0u);
        unsigned incl = packed;
#pragma unroll
        for (int o = 1; o < 64; o <<= 1) { const unsigned t2 = __shfl_up(incl, o); if (lane >= o) incl += t2; }
        if (lane == 63) cnt[16 + wave] = incl;
        __syncthreads();
        unsigned woff = 0u, total = 0u;
#pragma unroll
        for (int w2 = 0; w2 < 8; ++w2) { const unsigned t2 = cnt[16 + w2]; total += t2; if (w2 < wave) woff += t2; }
        const unsigned excl = incl - packed + woff;
        const unsigned ngt = total & 0xffffu, need_eq = cap - ngt;
        unsigned pg = excl & 0xffffu, pe = excl >> 16;
        const int rowbase = e * rows_per_e + (isctx ? 2048 + b * 32 : b * 256);
        const int tokbase = isctx ? NLAT + b * TC : b * T;
        if (tid * 4 < n) {
#pragma unroll
            for (int k = 0; k < 4; ++k) {
                const int tokrow = tokbase + tid * 4 + k; int slot = -1;
                if (key[k] > thr) { slot = (int)pg; ++pg; }
                else if (key[k] == thr) { if (pe < need_eq) slot = (int)(ngt + pe); ++pe; }
                if (slot >= 0) { sel[slot] = tokrow; GATE[rowbase + slot] = av[k]; INV[(size_t)tokrow * 16 + e] = rowbase + slot; }
                else INV[(size_t)tokrow * 16 + e] = -1;
            }
        }
        __syncthreads();
        const unsigned char* H = WSP(unsigned char, WS_H2);
        for (int s0 = wave * 4; s0 < (int)cap; s0 += 32) {
            u32x4 ra[4];
#pragma unroll
            for (int q = 0; q < 4; ++q) ra[q] = *((const u32x4*)((const unsigned char*)H + (size_t)sel[s0 + q] * D) + lane);
#pragma unroll
            for (int q = 0; q < 4; ++q) *((u32x4*)(WSP(unsigned char, R_XS) + (size_t)(rowbase + s0 + q) * D) + lane) = ra[q];
        }
        __syncthreads();
    }
}
__device__ __forceinline__ void phase_gather(const Params& P, int nrows, bool fp8, int vcu, int G) {
    const int lane = threadIdx.x & 63, wave = __builtin_amdgcn_readfirstlane(threadIdx.x >> 6);
    const int* TOK = WSP(int, WS_TOK); const bf16_t* H = WSP(bf16_t, WS_HBUF); bf16_t* XS = WSP(bf16_t, R_XS);
    if (fp8) {
        unsigned char* XS8 = WSP(unsigned char, R_XS);
        for (int r = vcu * 8 + wave; r < nrows; r += G * 8) {
            const int src = TOK[r]; const u32x4* sp = (const u32x4*)(H + (size_t)src * D); const u32x4 a = sp[2 * lane], b = sp[2 * lane + 1];
            u32x4 o; o.x = pk4_fp8(bf_lo(a.x) * FP8_SX, bf_hi(a.x) * FP8_SX, bf_lo(a.y) * FP8_SX, bf_hi(a.y) * FP8_SX); o.y = pk4_fp8(bf_lo(a.z) * FP8_SX, bf_hi(a.z) * FP8_SX, bf_lo(a.w) * FP8_SX, bf_hi(a.w) * FP8_SX);
            o.z = pk4_fp8(bf_lo(b.x) * FP8_SX, bf_hi(b.x) * FP8_SX, bf_lo(b.y) * FP8_SX, bf_hi(b.y) * FP8_SX); o.w = pk4_fp8(bf_lo(b.z) * FP8_SX, bf_hi(b.z) * FP8_SX, bf_lo(b.w) * FP8_SX, bf_hi(b.w) * FP8_SX);
            *(u32x4*)(XS8 + (size_t)r * D + 16 * lane) = o;
        }
        return;
    }
    for (int r = vcu * 8 + wave; r < nrows; r += G * 8) {
        const int src = TOK[r]; const u32x4* s = (const u32x4*)(H + (size_t)src * D); u32x4* d = (u32x4*)(XS + (size_t)r * D);
        const u32x4 a = s[lane], b = s[lane + 64]; d[lane] = a; d[lane + 64] = b;
    }
}
__device__ __forceinline__ void phase_combine(const Params& P, int l, int nrows, bool final_, int vcu, int G) {
    const int lane = threadIdx.x & 63, wave = __builtin_amdgcn_readfirstlane(threadIdx.x >> 6);
    const float* MOD = WSP(float, WS_MOD); bf16_t* XR = WSP(bf16_t, WS_XR); const int* INV = WSP(int, WS_INV); const bf16_t* YS = WSP(bf16_t, R_YS); bf16_t* H = WSP(bf16_t, WS_HBUF);
    for (int ri = 0; ri < (nrows > NLAT ? 9 : 8); ++ri) { const int row = grp_row(ri, wave);
        const int ci = row_cond(row);
        f32x4 v[4], a[4]; row_load_bf16(XR + (size_t)row * D, lane, v);
#pragma unroll
        for (int j = 0; j < 4; ++j) a[j] = (f32x4){0.f, 0.f, 0.f, 0.f};
        const int myinv = INV[(size_t)row * 16 + (lane & 15)];
        for (int e = 0; e < 16; ++e) {
            const int r = __shfl(myinv, e);
            if (r >= 0) {
#pragma unroll
                for (int j = 0; j < 4; ++j) { const int w = *(const int*)((const unsigned char*)YS + (size_t)r * D + 4 * lane + 256 * j);
                    const f32x2 lo = __builtin_amdgcn_cvt_pk_f32_fp8(w, false), hi = __builtin_amdgcn_cvt_pk_f32_fp8(w, true);
                    a[j][0] += lo[0] * (1.0f / FP8_SO); a[j][1] += lo[1] * (1.0f / FP8_SO); a[j][2] += hi[0] * (1.0f / FP8_SO); a[j][3] += hi[1] * (1.0f / FP8_SO); }
                if (row >= NLAT) {
                    const int ee = r / 2304, i2 = ee * 256 + (r - ee * 2304 - 2048);
#pragma unroll
                    for (int sl = 0; sl < 3; ++sl)
#pragma unroll
                        for (int j = 0; j < 4; ++j) { const u32x2 w = *(const u32x2*)(WSP(bf16_t, R_YS2) + ((size_t)sl * 4096 + i2) * D + 4 * lane + 256 * j);
                            a[j][0] += bf_lo(w.x); a[j][1] += bf_hi(w.x); a[j][2] += bf_lo(w.y); a[j][3] += bf_hi(w.y); }
                }
            }
        }
        const float* g2 = MOD + (size_t)(l * 9 + ci) * 6144 + 5120;
#pragma unroll
        for (int j = 0; j < 4; ++j) { const f32x4 gg = *(const f32x4*)(g2 + 4 * lane + 256 * j); v[j] = v[j] + gg * a[j]; }
        const float rstd = row_rstd(v);
        if (final_) {
#pragma unroll
            for (int j = 0; j < 4; ++j) { const f32x4 gg = *(const f32x4*)(P.final_g + 4 * lane + 256 * j); *(f32x4*)(P.out + (size_t)row * D + 4 * lane + 256 * j) = v[j] * rstd * gg; }
        } else {
            row_store_bf16(XR + (size_t)row * D, lane, v);
            f32x4 h[4]; const float* m = MOD + (size_t)((l + 1) * 9 + ci) * 6144;
            row_modulate(v, rstd, P.norm1_g + (l + 1) * 1024, m, m + 1024, lane, h);
#pragma unroll
            for (int j = 0; j < 4; ++j) *(unsigned*)((unsigned char*)H + (size_t)row * D + 4 * lane + 256 * j) = pk4_fp8(h[j][0] * FP8_SX, h[j][1] * FP8_SX, h[j][2] * FP8_SX, h[j][3] * FP8_SX);
        }
    }
}
__device__ __forceinline__ void phase_gate(const Params& P, int vcu, int G) {
    const int lane = threadIdx.x & 63, wave = __builtin_amdgcn_readfirstlane(threadIdx.x >> 6);
    const bf16_t* QKG = WSP(bf16_t, R_QKG); bf16_t* OF = WSP(bf16_t, R_OF); const bf16_t* OB = WSP(bf16_t, R_OB); const float* GN = WSP(float, WS_GNST);
    for (int ri = 0; ri < 9; ++ri) { const int row = grp_row(ri, wave);
#pragma unroll
        for (int hh = 0; hh < 4; ++hh) {
            float mu[2], rs[2];
#pragma unroll
            for (int d = 0; d < 2; ++d) { const f32x4* st = (const f32x4*)(GN + ((size_t)(d * NROW + row) * 4 + hh) * 8); const f32x4 s0 = st[0], s1 = st[1];
                const float sum = (s0[0] + s0[2]) + (s1[0] + s1[2]), sq = (s0[1] + s0[3]) + (s1[1] + s1[3]);
                mu[d] = sum * (1.0f / 512.0f); const float var = fmaxf(sq * (1.0f / 512.0f) - mu[d] * mu[d], 0.f); rs[d] = 1.0f / sqrtf(var + 1e-6f); }
            const int col = 512 * hh + 8 * lane;
            const u32x4 of = *(const u32x4*)(OF + (size_t)row * 2048 + col), ob = *(const u32x4*)(OB + (size_t)row * 2048 + col);
            const u32x4 gf = *(const u32x4*)(QKG + (size_t)row * QKG_LD + 2048 + col), gb = *(const u32x4*)(QKG + (size_t)row * QKG_LD + 4096 + col);
            const f32x4 nf0 = *(const f32x4*)(P.ret_gn_f + col), nf1 = *(const f32x4*)(P.ret_gn_f + col + 4), nb0 = *(const f32x4*)(P.ret_gn_b + col), nb1 = *(const f32x4*)(P.ret_gn_b + col + 4);
            const float gnf[8] = {nf0[0], nf0[1], nf0[2], nf0[3], nf1[0], nf1[1], nf1[2], nf1[3]}, gnb[8] = {nb0[0], nb0[1], nb0[2], nb0[3], nb1[0], nb1[1], nb1[2], nb1[3]};
            float y[8];
#pragma unroll
            for (int q = 0; q < 4; ++q) {
                const float f0 = bf_lo(of[q]), f1 = bf_hi(of[q]), b0 = bf_lo(ob[q]), b1 = bf_hi(ob[q]);
                const float gf0 = bf_lo(gf[q]), gf1 = bf_hi(gf[q]), gb0 = bf_lo(gb[q]), gb1 = bf_hi(gb[q]);
                y[2 * q] = silu_f(gf0) * ((f0 - mu[0]) * rs[0] * gnf[2 * q]) + silu_f(gb0) * ((b0 - mu[1]) * rs[1] * gnb[2 * q]);
                y[2 * q + 1] = silu_f(gf1) * ((f1 - mu[0]) * rs[0] * gnf[2 * q + 1]) + silu_f(gb1) * ((b1 - mu[1]) * rs[1] * gnb[2 * q + 1]);
            }
            u32x4 w; w.x = cvt_pk_bf16(y[0], y[1]); w.y = cvt_pk_bf16(y[2], y[3]); w.z = cvt_pk_bf16(y[4], y[5]); w.w = cvt_pk_bf16(y[6], y[7]);
            *(u32x4*)(OF + (size_t)row * 2048 + col) = w;
        }
    }
}

typedef short v4i16_t __attribute__((ext_vector_type(4)));
__device__ __forceinline__ s16x4 lds_tr(LAS unsigned char* p) { return __builtin_bit_cast(s16x4, __builtin_amdgcn_ds_read_tr16_b64_v4i16((LAS v4i16_t*)p)); }
__device__ __forceinline__ bf16x8 cat8(s16x4 lo, s16x4 hi) { return __builtin_shufflevector(lo, hi, 0, 1, 2, 3, 4, 5, 6, 7); }
__device__ __forceinline__ bf16x8 pack8(const f32x4 a, const f32x4 b) { u32x4 w; w.x = cvt_pk_bf16(a[0], a[1]); w.y = cvt_pk_bf16(a[2], a[3]); w.z = cvt_pk_bf16(b[0], b[1]); w.w = cvt_pk_bf16(b[2], b[3]); return __builtin_bit_cast(bf16x8, w); }
__device__ __forceinline__ int fswz_qk(int row) { return ((row >> 2) & 1) | (((row >> 1) & 1) << 1) | (((row >> 3) & 1) << 2); }
__device__ __forceinline__ void scan_dma(const bf16_t* QKG, int R0, int h, int t, LAS unsigned char* slot, int w, int lane) {
#pragma unroll
    for (int i = 0; i < 2; ++i) { const int q = w * 2 + i, row = 8 * q + (lane >> 3), cc = (lane & 7) ^ fswz_qk(row);
        const bf16_t* src = QKG + (size_t)(R0 + row) * QKG_LD + h * 256 + 64 * t + cc * 8;
        __builtin_amdgcn_global_load_lds((const unsigned*)src, (LAS unsigned*)(slot + q * 1024), 16, 0, 0);
        __builtin_amdgcn_global_load_lds((const unsigned*)(src + 1024), (LAS unsigned*)(slot + 16384 + q * 1024), 16, 0, 0); }
}
#define SCAN_SB() __builtin_amdgcn_sched_barrier(0)
template <int TT>
__device__ __forceinline__ void scan_tile_a(LAS unsigned char* slot, const f32x4 (&sacc)[16], f32x4 (&oacc)[8], f32x4 (&pacc)[8], const int (&qoff)[2][2], int w) {
    LAS unsigned char* Qt = slot; LAS unsigned char* Kt = slot + 16384;
    bf16x8 kA[2], sA[2];
    s16x4 qc[4], qn[4];
#pragma unroll
    for (int ks2 = 0; ks2 < 2; ++ks2) {
        kA[ks2] = cat8(*(const LAS s16x4*)(Kt + w * 2048 + qoff[ks2][0]), *(const LAS s16x4*)(Kt + w * 2048 + qoff[ks2][1]));
        sA[ks2] = pack8(sacc[4 * TT + 2 * ks2], sacc[4 * TT + 2 * ks2 + 1]); }
#pragma unroll
    for (int q = 0; q < 4; ++q) qc[q] = *(const LAS s16x4*)(Qt + qoff[q >> 1][q & 1]);
    SCAN_SB();
#pragma unroll
    for (int it = 0; it < 8; ++it) {
        if (it < 7) {
#pragma unroll
            for (int q = 0; q < 4; ++q) qn[q] = *(const LAS s16x4*)(Qt + (it + 1) * 2048 + qoff[q >> 1][q & 1]); }
        const bf16x8 q0 = cat8(qc[0], qc[1]), q1 = cat8(qc[2], qc[3]);
        pacc[it] = __builtin_amdgcn_mfma_f32_16x16x32_bf16(kA[0], q0, pacc[it], 0, 0, 0);
        oacc[it] = __builtin_amdgcn_mfma_f32_16x16x32_bf16(sA[0], q0, oacc[it], 0, 0, 0);
        pacc[it] = __builtin_amdgcn_mfma_f32_16x16x32_bf16(kA[1], q1, pacc[it], 0, 0, 0);
        oacc[it] = __builtin_amdgcn_mfma_f32_16x16x32_bf16(sA[1], q1, oacc[it], 0, 0, 0);
        SCAN_SB();
#pragma unroll
        for (int q = 0; q < 4; ++q) qc[q] = qn[q];
    }
}
template <int TT>
__device__ __forceinline__ void scan_tile_b(LAS unsigned char* slot, f32x4 (&sacc)[16], const bf16x8 (&vd)[4], const int (&vbase)[2], const int (&doff)[4], float cd) {
    LAS unsigned char* Kt = slot + 16384;
    s16x4 ac[8], an[8];
#pragma unroll
    for (int dt = 0; dt < 4; ++dt) { ac[2 * dt] = lds_tr(Kt + vbase[0] + doff[dt]); ac[2 * dt + 1] = lds_tr(Kt + vbase[1] + doff[dt]); }
#pragma unroll
    for (int dt = 0; dt < 4; ++dt) sacc[4 * TT + dt] = sacc[4 * TT + dt] * cd;
    SCAN_SB();
#pragma unroll
    for (int ks = 0; ks < 4; ++ks) {
        if (ks < 3) {
#pragma unroll
            for (int dt = 0; dt < 4; ++dt) { an[2 * dt] = lds_tr(Kt + (ks + 1) * 4096 + vbase[0] + doff[dt]); an[2 * dt + 1] = lds_tr(Kt + (ks + 1) * 4096 + vbase[1] + doff[dt]); } }
#pragma unroll
        for (int dt = 0; dt < 4; ++dt) sacc[4 * TT + dt] = __builtin_amdgcn_mfma_f32_16x16x32_bf16(cat8(ac[2 * dt], ac[2 * dt + 1]), vd[ks], sacc[4 * TT + dt], 0, 0, 0);
        SCAN_SB();
#pragma unroll
        for (int q = 0; q < 8; ++q) ac[q] = an[q];
    }
}
__device__ __forceinline__ void scan_step_sync(bool dma_issued) {
    if (dma_issued) asm volatile("s_waitcnt vmcnt(4) lgkmcnt(0)" ::: "memory"); else asm volatile("s_waitcnt vmcnt(0) lgkmcnt(0)" ::: "memory");
    __builtin_amdgcn_s_barrier(); asm volatile("" ::: "memory");
}
__device__ __forceinline__ void phase_scan(const Params& P, LAS unsigned char* lds, int vcu, int G) {
    const int tid = threadIdx.x, lane = tid & 63, w = __builtin_amdgcn_readfirstlane(tid >> 6), l15 = lane & 15, g = lane >> 4;
    const bf16_t* QKG = WSP(bf16_t, R_QKG); const bf16_t* VT = WSP(bf16_t, R_VT); float* GN = WSP(float, WS_GNST);
    LAS unsigned char* PT = lds + 98304;
    LAS float* ST = (LAS float*)(lds + 98304 + 34816);
    LAS float* kdT = (LAS float*)(lds + 98304 + 34816 + 8192);
    LAS float* qdT = kdT + 128;
    LAS float* dcT = kdT + 256;
    int qoff[2][2], vbase[2], doff[4];
#pragma unroll
    for (int ks2 = 0; ks2 < 2; ++ks2)
#pragma unroll
        for (int hf = 0; hf < 2; ++hf) qoff[ks2][hf] = l15 * 128 + (((4 * ks2 + 2 * hf + (g >> 1)) ^ fswz_qk(l15)) * 16) + 8 * (g & 1);
    { const int qq = l15 >> 2, p = lane & 3, f0 = ((qq >> 1) << 1) | ((g & 1) << 2);
#pragma unroll
      for (int t = 0; t < 2; ++t) vbase[t] = (8 * g + 4 * t + qq) * 128 + (((p >> 1) ^ t) * 16) + 8 * (p & 1);
#pragma unroll
      for (int dt = 0; dt < 4; ++dt) doff[dt] = 32 * (dt ^ (f0 >> 1)); }
    if (vcu < 256) {
        const int unit = vcu;
        const int bh = unit >> 3, b = bh >> 2, h = bh & 3, dir = (unit >> 2) & 1, s = unit & 3;
        const int n0 = h * 512 + s * 128;
        bf16_t* OX = WSP(bf16_t, dir ? R_OB : R_OF);
        const float xd = (dir ? P.ret_decay_b : P.ret_decay_f)[h];
        const float lg2 = -log1pf(expf(-xd)) * LOG2E;
        const float cd = exp2f(128.0f * lg2);
        f32x4 sacc[16], oacc[8], pacc[8];
#pragma unroll
        for (int i = 0; i < 16; ++i) sacc[i] = (f32x4){0.f, 0.f, 0.f, 0.f};
#pragma unroll
        for (int i = 0; i < 8; ++i) { oacc[i] = (f32x4){0.f, 0.f, 0.f, 0.f}; pacc[i] = (f32x4){0.f, 0.f, 0.f, 0.f}; }
        int cs = 0;
        { const int R00 = dir ? NLAT + b * TC + 128 : NLAT + b * TC; scan_dma(QKG, R00, h, 0, lds, w, lane); scan_dma(QKG, R00, h, 1, lds + 32768, w, lane); }
        if (tid < 128) { kdT[tid] = exp2f((float)(dir ? tid : 127 - tid) * lg2); qdT[tid] = exp2f((float)(dir ? 128 - tid : tid + 1) * lg2); dcT[tid] = exp2f((float)tid * lg2); }
        scan_step_sync(true);
#define SCAN_ROTATE() do { const int ncs = cs == 2 ? 0 : cs + 1; const int dl = (ncs - cs) * 32768; cs = ncs; \
            qoff[0][0] += dl; qoff[0][1] += dl; qoff[1][0] += dl; qoff[1][1] += dl; vbase[0] += dl; vbase[1] += dl; } while (0)
#define SCAN_DSLOT() (lds + (cs == 0 ? 65536 : (cs == 1 ? 0 : 32768)))
        for (int c = 0; c < 18; ++c) {
            int R0, R1;
            if (!dir) { R0 = c < 2 ? NLAT + b * TC + c * 128 : b * T + (c - 2) * 128; R1 = (c + 1) < 2 ? NLAT + b * TC + (c + 1) * 128 : b * T + (c - 1) * 128; }
            else { R0 = c < 2 ? NLAT + b * TC + (1 - c) * 128 : b * T + (17 - c) * 128; R1 = (c + 1) < 2 ? NLAT + b * TC + (0 - c) * 128 : b * T + (16 - c) * 128; }
            const bool more = c < 17;
            bf16x8 vf[4], vd[4];
            const bf16_t* vsrc = VT + (size_t)(n0 + 16 * w + l15) * NROW + R0 + 8 * g;
#pragma unroll
            for (int ks = 0; ks < 4; ++ks) vf[ks] = *(const bf16x8*)(vsrc + 32 * ks);
            asm volatile("" ::: "memory");
            scan_dma(QKG, R0, h, 2, SCAN_DSLOT(), w, lane);
            scan_tile_a<0>(lds, sacc, oacc, pacc, qoff, w);
#pragma unroll
            for (int ks = 0; ks < 4; ++ks) { const u32x4 raw = __builtin_bit_cast(u32x4, vf[ks]); u32x4 o;
                const f32x4 ka = *(const LAS f32x4*)(kdT + 32 * ks + 8 * g), kb = *(const LAS f32x4*)(kdT + 32 * ks + 8 * g + 4);
                o[0] = cvt_pk_bf16(bf_lo(raw[0]) * ka[0], bf_hi(raw[0]) * ka[1]); o[1] = cvt_pk_bf16(bf_lo(raw[1]) * ka[2], bf_hi(raw[1]) * ka[3]);
                o[2] = cvt_pk_bf16(bf_lo(raw[2]) * kb[0], bf_hi(raw[2]) * kb[1]); o[3] = cvt_pk_bf16(bf_lo(raw[3]) * kb[2], bf_hi(raw[3]) * kb[3]);
                vd[ks] = __builtin_bit_cast(bf16x8, o); }
            scan_tile_b<0>(lds, sacc, vd, vbase, doff, cd);
            scan_step_sync(true); SCAN_ROTATE();
            scan_dma(QKG, R0, h, 3, SCAN_DSLOT(), w, lane);
            scan_tile_a<1>(lds, sacc, oacc, pacc, qoff, w); scan_tile_b<1>(lds, sacc, vd, vbase, doff, cd);
            scan_step_sync(true); SCAN_ROTATE();
            if (more) scan_dma(QKG, R1, h, 0, SCAN_DSLOT(), w, lane);
            scan_tile_a<2>(lds, sacc, oacc, pacc, qoff, w); scan_tile_b<2>(lds, sacc, vd, vbase, doff, cd);
            scan_step_sync(more); SCAN_ROTATE();
            { const bf16_t* vs2 = vsrc; asm volatile("" : "+v"(vs2));
#pragma unroll
              for (int ks = 0; ks < 4; ++ks) vf[ks] = *(const bf16x8*)(vs2 + 32 * ks); }
            asm volatile("" ::: "memory");
            if (more) scan_dma(QKG, R1, h, 1, SCAN_DSLOT(), w, lane);
            scan_tile_a<3>(lds, sacc, oacc, pacc, qoff, w); scan_tile_b<3>(lds, sacc, vd, vbase, doff, cd);
            int d0 = dir ? (16 * w + 4 * g) - l15 : l15 - (16 * w + 4 * g); asm volatile("" : "+v"(d0));
            const int sgn = dir ? -1 : 1;
            LAS unsigned char* ptw = PT + l15 * 272 + (16 * w + 4 * g) * 2;
            LAS unsigned char* ptr_ = PT + l15 * 272 + 16 * g;
            const LAS float* qdp = qdT + l15;
            LAS float* stp = ST + (w * 128 + l15) * 2;
            bf16_t* oxp = OX + (size_t)(R0 + l15) * 2048 + n0 + 16 * w + 4 * g;
#pragma unroll
            for (int it = 0; it < 8; ++it) { float pv[4];
#pragma unroll
                for (int r = 0; r < 4; ++r) { const int diff = d0 + sgn * (16 * it - r);
                    const float dv = dcT[diff < 0 ? 0 : diff];
                    pv[r] = diff >= 0 ? pacc[it][r] * dv : 0.f; }
                u32x2 wv; wv.x = cvt_pk_bf16(pv[0], pv[1]); wv.y = cvt_pk_bf16(pv[2], pv[3]);
                *(LAS u32x2*)(ptw + it * 4352) = wv;
                pacc[it] = (f32x4){0.f, 0.f, 0.f, 0.f}; }
            wg_sync_lds();
#pragma unroll
            for (int it = 0; it < 8; ++it) oacc[it] = oacc[it] * qdp[16 * it];
#pragma unroll
            for (int ks = 0; ks < 4; ++ks)
#pragma unroll
                for (int it = 0; it < 8; ++it) { const bf16x8 pb = *(const LAS bf16x8*)(ptr_ + it * 4352 + ks * 64);
                    oacc[it] = __builtin_amdgcn_mfma_f32_16x16x32_bf16(vf[ks], pb, oacc[it], 0, 0, 0); }
#pragma unroll
            for (int it = 0; it < 8; ++it) {
                const f32x4 o = oacc[it];
                float s1 = (o[0] + o[1]) + (o[2] + o[3]), s2 = (o[0] * o[0] + o[1] * o[1]) + (o[2] * o[2] + o[3] * o[3]);
                s1 = sum_x16x32(s1); s2 = sum_x16x32(s2);
                if (g == 0) { stp[32 * it] = s1; stp[32 * it + 1] = s2; } }
            scan_step_sync(more); SCAN_ROTATE();
#pragma unroll
            for (int it = 0; it < 8; ++it) { const f32x4 o = oacc[it];
                u32x2 wv; wv.x = cvt_pk_bf16(o[0], o[1]); wv.y = cvt_pk_bf16(o[2], o[3]);
                *(u32x2*)(oxp + (size_t)it * 16 * 2048) = wv;
                oacc[it] = (f32x4){0.f, 0.f, 0.f, 0.f}; }
            if (tid < 128) { float s1 = 0.f, s2 = 0.f;
#pragma unroll
                for (int w2 = 0; w2 < 8; ++w2) { s1 += ST[(w2 * 128 + tid) * 2]; s2 += ST[(w2 * 128 + tid) * 2 + 1]; }
                float* gp = GN + ((size_t)(dir * NROW + R0 + tid) * 4 + h) * 8 + s * 2; gp[0] = s1; gp[1] = s2; }
        }
#undef SCAN_ROTATE
#undef SCAN_DSLOT
        wg_sync();
    }
}

__device__ __forceinline__ int fswz_k(int row) { return (row >> 1) & 7; }
__device__ __forceinline__ int fswz_v(int row) { return (((row >> 1) & 3) << 1) | ((row >> 3) & 1); }
__device__ __forceinline__ void attn_dma(const bf16_t* QKV, int rowbase, int kvh, LAS unsigned char* slot, int w, int lane) {
    const int row = 8 * w + (lane >> 3), pc = lane & 7;
    const bf16_t* src = QKV + (size_t)(rowbase + row) * QKV_LD + kvh * 64;
    __builtin_amdgcn_global_load_lds((const unsigned*)(src + 1024 + ((pc ^ fswz_k(row)) * 8)), (LAS unsigned*)(slot + w * 1024), 16, 0, 0);
    __builtin_amdgcn_global_load_lds((const unsigned*)(src + 1152 + ((pc ^ fswz_v(row)) * 8)), (LAS unsigned*)(slot + 8192 + w * 1024), 16, 0, 0);
}
__device__ __forceinline__ void phase_attn(const Params& P, LAS unsigned char* lds, int vcu, int G) {
    const int tid = threadIdx.x, lane = tid & 63, w = __builtin_amdgcn_readfirstlane(tid >> 6), l15 = lane & 15, g = lane >> 4;
    const bf16_t* QKV = WSP(bf16_t, R_QKV); bf16_t* O1 = WSP(bf16_t, R_O1);
    int koff[2], vtb, vdoff[4];
#pragma unroll
    for (int ks = 0; ks < 2; ++ks) koff[ks] = l15 * 128 + (((4 * ks + g) ^ fswz_k(l15)) * 16);
    { const int qq = l15 >> 2, p = lane & 3, fv = fswz_v(4 * g + qq);
      vtb = (4 * g + qq) * 128 + (((p >> 1) ^ (fv & 1)) * 16) + 8 * (p & 1);
#pragma unroll
      for (int dt = 0; dt < 4; ++dt) vdoff[dt] = 32 * (dt ^ (fv >> 1)); }
    for (int it = 0; it < 2; ++it) { const int ui = 64 * ((int)blockIdx.x & 7) + 32 * it + ((int)blockIdx.x >> 3);
        const int b = ui >> 6, kvh = (ui >> 5) & 1, qb = ui & 31, q0 = 64 * qb, hq = kvh * 8 + w;
        const int wt_lo = qb >= 2 ? 0 : 2 - qb, wt_hi = (33 - qb) < 4 ? (33 - qb) : 4, nt = 4 + (wt_hi - wt_lo + 1);
        bf16x8 qf[4][2];
#pragma unroll
        for (int qt = 0; qt < 4; ++qt)
#pragma unroll
            for (int ks = 0; ks < 2; ++ks) qf[qt][ks] = *(const bf16x8*)(QKV + (size_t)(b * T + q0 + 16 * qt + l15) * QKV_LD + hq * 64 + 32 * ks + 8 * g);
        float mrun[4], lrun[4]; f32x4 oacc[4][4];
#pragma unroll
        for (int qt = 0; qt < 4; ++qt) { mrun[qt] = -1e30f; lrun[qt] = 0.f;
#pragma unroll
            for (int dt = 0; dt < 4; ++dt) oacc[dt][qt] = (f32x4){0.f, 0.f, 0.f, 0.f}; }
        attn_dma(QKV, NLAT + b * TC, kvh, lds, w, lane);
        wg_sync();
        for (int ti = 0; ti < nt; ++ti) {
            LAS unsigned char* slot = lds + (ti & 1) * 16384;
            const int wt = wt_lo + ti - 4;
            if (ti + 1 < nt) { const int tn = ti + 1; const int rb = tn < 4 ? NLAT + b * TC + 64 * tn : b * T + q0 - 128 + 64 * (wt_lo + tn - 4);
                attn_dma(QKV, rb, kvh, lds + (tn & 1) * 16384, w, lane); }
            f32x4 sc[4][4];
#pragma unroll
            for (int kt = 0; kt < 4; ++kt) {
                const bf16x8 a0 = *(const LAS bf16x8*)(slot + kt * 2048 + koff[0]), a1 = *(const LAS bf16x8*)(slot + kt * 2048 + koff[1]);
#pragma unroll
                for (int qt = 0; qt < 4; ++qt) { f32x4 z = (f32x4){0.f, 0.f, 0.f, 0.f};
                    z = __builtin_amdgcn_mfma_f32_16x16x32_bf16(a0, qf[qt][0], z, 0, 0, 0);
                    sc[kt][qt] = __builtin_amdgcn_mfma_f32_16x16x32_bf16(a1, qf[qt][1], z, 0, 0, 0); } }
            __builtin_amdgcn_sched_barrier(0);
            const int mtype = (ti >= 4 && wt == 0) ? 1 : ((ti >= 4 && wt == 4) ? 2 : 0);
            if (mtype != 0) {
#pragma unroll
                for (int qt = 0; qt < 4; ++qt) { const int qi = 16 * qt + l15;
#pragma unroll
                    for (int kt = 0; kt < 4; ++kt)
#pragma unroll
                        for (int r = 0; r < 4; ++r) { const int kl = 16 * kt + 4 * g + r; const bool dead = (mtype == 1) ? (kl < qi) : (kl > qi); if (dead) sc[kt][qt][r] = -INFINITY; } }
            }
            bf16x8 pf[4][2];
#pragma unroll
            for (int qt = 0; qt < 4; ++qt) {
                float mx = -1e30f;
#pragma unroll
                for (int kt = 0; kt < 4; ++kt)
#pragma unroll
                    for (int r = 0; r < 4; ++r) mx = fmaxf(mx, sc[kt][qt][r]);
                mx = max_x16x32(mx);
                const float mnew = fmaxf(mrun[qt], mx * LOG2E), alpha = __builtin_amdgcn_exp2f(mrun[qt] - mnew); mrun[qt] = mnew;
                f32x4 ls4 = {0.f, 0.f, 0.f, 0.f};
#pragma unroll
                for (int kt = 0; kt < 4; ++kt) { const f32x4 t = sc[kt][qt] * LOG2E - mnew; f32x4 pv;
#pragma unroll
                    for (int r = 0; r < 4; ++r) pv[r] = __builtin_amdgcn_exp2f(t[r]);
                    sc[kt][qt] = pv; ls4 = ls4 + pv; }
                const float ls = (ls4[0] + ls4[1]) + (ls4[2] + ls4[3]);
                lrun[qt] = lrun[qt] * alpha + ls;
#pragma unroll
                for (int dt = 0; dt < 4; ++dt) oacc[dt][qt] = oacc[dt][qt] * alpha;
                pf[qt][0] = pack8(sc[0][qt], sc[1][qt]); pf[qt][1] = pack8(sc[2][qt], sc[3][qt]);
            }
            __builtin_amdgcn_sched_barrier(0);
#pragma unroll
            for (int dt = 0; dt < 4; ++dt)
#pragma unroll
                for (int kk = 0; kk < 2; ++kk) {
                    const bf16x8 a = cat8(lds_tr(slot + 8192 + kk * 4096 + vtb + vdoff[dt]), lds_tr(slot + 8192 + kk * 4096 + 2048 + vtb + vdoff[dt]));
#pragma unroll
                    for (int qt = 0; qt < 4; ++qt) oacc[dt][qt] = __builtin_amdgcn_mfma_f32_16x16x32_bf16(a, pf[qt][kk], oacc[dt][qt], 0, 0, 0);
                    __builtin_amdgcn_sched_barrier(0);
                }
            wg_sync();
        }
        const float sink2 = P.swa_sink[hq] * LOG2E;
#pragma unroll
        for (int qt = 0; qt < 4; ++qt) {
            float l = sum_x16x32(lrun[qt]); l += __builtin_amdgcn_exp2f(sink2 - mrun[qt]);
            const float inv = 1.0f / l;
#pragma unroll
            for (int dt = 0; dt < 4; ++dt) { const f32x4 o = oacc[dt][qt] * (inv * FP8_SX);
                *(unsigned*)((unsigned char*)O1 + (size_t)(b * T + q0 + 16 * qt + l15) * D + hq * 64 + 16 * dt + 4 * g) = pk4_fp8(o[0], o[1], o[2], o[3]); }
        }
    }
}

constexpr int NPHASE = 21;
#ifndef PH_MASK
#define PH_MASK 0xffffffffu
#endif
#define IN(k) ((((PH_MASK) >> (k)) & 1u) && lo <= (k) && (k) < hi)
#define BOTH(k) (IN(k) && IN((k) + 1))
#define GRID_BAR() do { if (MK_ONE_LAUNCH) xcd_barrier(bar); } while (0)
#define GRP_BAR() do { if (MK_ONE_LAUNCH) grp_barrier(WSP(unsigned, WS_CTL), MISC); } while (0)

__global__ void __launch_bounds__(512, 2) mega_fwd(Params P) {
    extern __shared__ __attribute__((aligned(16))) unsigned char lds_raw[];
    LAS unsigned char* lds = (LAS unsigned char*)lds_raw;
    const int tid = threadIdx.x, G = gridDim.x;
    const int bx = blockIdx.x, vcu = (G % 8 == 0) ? (bx % 8) * (G / 8) + bx / 8 : bx;
    volatile LAS unsigned* MISC = (volatile LAS unsigned*)(lds + LDS_MISC);
    if (tid < 4) MISC[tid] = 0u;
    __syncthreads();
    XcdBarrier bar; bar.bar = WSP(unsigned, WS_CTL); bar.x = 0; bar.st = MISC;
    if (MK_ONE_LAUNCH) { bar = xcd_barrier_post(WSP(unsigned, WS_CTL), MISC); if (tid == 0) __hip_atomic_store(WSP(unsigned, WS_CTL) + GB_XTAB + bx, xb_xcc_id() + 1u, __ATOMIC_RELAXED, __HIP_MEMORY_SCOPE_AGENT); }
    const int lo = P.ph_lo, hi = P.ph_hi;

    if (IN(0)) { phase_prologue(P, lds, vcu, G); if (BOTH(0)) GRID_BAR(); }
    if (IN(1)) { phase_norm1_l0(P, vcu, G); if (BOTH(1)) GRP_BAR(); }
    if (IN(2)) {
        const int kx = bx >> 3; const bool split = (G == 256), conv = split && (kx >= 32 - CONV_PX);
        if (!conv) {
            SchedIn S{WSP(bf16_t, WS_HBUF), WSP(bf16_t, WS_WQKG), WSP(bf16_t, WS_WV), 32 - CONV_PX, bx & 7, kx};
            EpiIn E{WSP(bf16_t, R_QKG), WSP(bf16_t, R_VT)};
            pg8::gemm_phase<EpiIn, SchedIn>(lds, pg8::Gemm{1024, 1024}, S, E);
            __syncthreads();
        }
        moe_convert_pool(P, lds, WSP(unsigned, WS_CTL) + 8192);
        if (BOTH(2)) GRP_BAR();
    }
    if (IN(3)) { phase_scan(P, lds, vcu, G); if (BOTH(3)) GRP_BAR(); }
    if (IN(4)) { phase_gate(P, vcu, G); if (BOTH(4)) GRP_BAR(); }
    if (IN(5)) {
        SchedRO S{WSP(bf16_t, R_OF), WSP(bf16_t, WS_WRO), G, bx};
        EpiRes E{P.x, P.ctx, nullptr, WSP(float, WS_MOD) + 2048, WSP(bf16_t, WS_XR), WSP(float, R_XRP), 1.0f};
        pg8::gemm_phase<EpiRes, SchedRO>(lds, pg8::Gemm{2048, 2048}, S, E);
        if (BOTH(5)) GRP_BAR();
    }
    if (IN(6)) { phase_norm2_router<true>(P, lds, 0, NROW, G); if (BOTH(6)) GRID_BAR(); }
    if (IN(7)) { phase_topk(P, lds, 0, G); if (IN(9)) GRP_BAR(); }
    if (IN(9)) {
        SchedGrouped S{WSP(bf16_t, R_XS), WSP(bf16_t, WS_GU), 512, 512, 9, 16, G, bx};
        EpiGU E{WSP(bf16_t, R_HID), 1};
        pg8::gemm_phase<EpiGU, SchedGrouped, true>(lds, pg8::Gemm{512, 512}, S, E);
        if (BOTH(9)) GRP_BAR();
    }
    if (IN(10)) {
        SchedDown0 S{WSP(bf16_t, R_HID), WSP(bf16_t, WS_DW), G, bx, 1024};
        EpiDown E{WSP(bf16_t, R_YS), WSP(float, WS_GATE), WSP(bf16_t, R_YS2), 1.0f / (FP8_SH * FP8_SW)};
        pg8::gemm_phase<EpiDown, SchedDown0, true>(lds, pg8::Gemm{1024, 1024}, S, E);
        if (BOTH(10)) GRID_BAR();
    }
    if (IN(11)) { phase_combine(P, 0, NROW, false, vcu, G); if (BOTH(11)) GRP_BAR(); }
    if (IN(12)) {
        SchedQkv S{WSP(bf16_t, WS_HBUF), WSP(bf16_t, WS_WQKV), G, bx};
        EpiQkv E{WSP(bf16_t, R_QKV), WSP(float, WS_ROPE), 1.0f / (FP8_SX * FP8_SW)};
        pg8::gemm_phase<EpiQkv, SchedQkv, true>(lds, pg8::Gemm{512, 512}, S, E);
        if (BOTH(12)) GRP_BAR();
    }
    if (IN(13)) { phase_attn(P, lds, vcu, G); if (BOTH(13)) GRP_BAR(); }
    if (IN(14)) {
        SchedPlain S{WSP(bf16_t, R_O1), WSP(bf16_t, WS_WSO), 512, 512, 64, 4, G, bx};
        EpiRes E{nullptr, nullptr, WSP(bf16_t, WS_XR), WSP(float, WS_MOD) + 9 * 6144 + 2048, WSP(bf16_t, WS_XR), nullptr, 1.0f / (FP8_SX * FP8_SW)};
        pg8::gemm_phase<EpiRes, SchedPlain, true>(lds, pg8::Gemm{512, 512}, S, E);
        if (BOTH(14)) GRP_BAR();
    }
    if (IN(15)) { phase_norm2_router<false>(P, lds, 1, NLAT, G); if (BOTH(15)) GRID_BAR(); }
    if (IN(16)) { phase_topk(P, lds, 1, G); if (IN(18)) GRP_BAR(); }
    if (IN(18)) {
        SchedGrouped S{WSP(bf16_t, R_XS), (const bf16_t*)(WSP(unsigned char, WS_GU) + (size_t)NE * 4096 * 1024), 512, 512, 8, 16, G, bx};
        EpiGU E{WSP(bf16_t, R_HID), 1};
        pg8::gemm_phase<EpiGU, SchedGrouped, true>(lds, pg8::Gemm{512, 512}, S, E);
        if (BOTH(18)) GRP_BAR();
    }
    if (IN(19)) {
        SchedGrouped S{WSP(bf16_t, R_HID), (const bf16_t*)(WSP(unsigned char, WS_DW) + (size_t)NE * 1024 * 2048), 1024, 1024, 8, 4, G, bx};
        EpiDown E{WSP(bf16_t, R_YS), WSP(float, WS_GATE), nullptr, 1.0f / (FP8_SH * FP8_SW)};
        pg8::gemm_phase<EpiDown, SchedGrouped, true>(lds, pg8::Gemm{1024, 1024}, S, E);
        if (BOTH(19)) GRID_BAR();
    }
    if (IN(20)) { phase_combine(P, 1, NLAT, true, vcu, G); }
}

#ifndef DBG_STOP
#define DBG_STOP -1
#endif
__global__ void dbg_dump(const float* src, float* out, size_t n) { for (size_t i = (size_t)blockIdx.x * blockDim.x + threadIdx.x; i < n; i += (size_t)gridDim.x * blockDim.x) out[i] = src[i]; }
__global__ void dbg_dump_bf16(const bf16_t* src, size_t nsrc, size_t mul, float* out, size_t n) { for (size_t i = (size_t)blockIdx.x * blockDim.x + threadIdx.x; i < n; i += (size_t)gridDim.x * blockDim.x) out[i] = __uint_as_float(((unsigned)src[(i * mul) % nsrc]) << 16); }
#ifndef DBG_SRC
#define DBG_SRC R_OF
#define DBG_N ((size_t)NROW * 4096)
#define DBG_MUL 5
#endif
extern "C" void kernel_launch(void* const* d_in, const int* in_sizes, int n_in, void* d_out, int out_size, void* d_ws, size_t ws_size, hipStream_t stream) {
    static int grid = 0;
    if (grid == 0) {
        if (n_in != 22 || ws_size < WS_END) { fprintf(stderr, "kernel_launch: expected 22 inputs and >= %zu bytes of workspace, got %d / %zu\n", (size_t)WS_END, n_in, ws_size); grid = -1; return; }
        int dev = 0, cus = 0, per_cu = 0;
        if (hipGetDevice(&dev) != hipSuccess || hipDeviceGetAttribute(&cus, hipDeviceAttributeMultiprocessorCount, dev) != hipSuccess) { grid = -1; return; }
        if (hipFuncSetAttribute((const void*)mega_fwd, hipFuncAttributeMaxDynamicSharedMemorySize, LDS_BYTES) != hipSuccess) { fprintf(stderr, "kernel_launch: hipFuncSetAttribute failed\n"); grid = -1; return; }
        if (hipOccupancyMaxActiveBlocksPerMultiprocessor(&per_cu, (const void*)mega_fwd, 512, LDS_BYTES) != hipSuccess || per_cu < 1) { fprintf(stderr, "kernel_launch: occupancy query says %d\n", per_cu); }
        (void)hipGetLastError();
        if (cus < 256) { fprintf(stderr, "kernel_launch: built for a 256-CU device, found %d\n", cus); grid = -1; return; }
        grid = 256;
    }
    if (grid < 0) return;
    (void)hipMemsetAsync((char*)d_ws + WS_CTL, 0, CTL_BYTES, stream);
    Params p{};
    p.x = (const float*)d_in[0]; p.c = (const float*)d_in[1]; p.ctx = (const float*)d_in[2]; p.c_ctx = (const float*)d_in[3]; p.ada_w = (const float*)d_in[4]; p.ada_b = (const float*)d_in[5];
    p.norm1_g = (const float*)d_in[6]; p.norm2_g = (const float*)d_in[7]; p.final_g = (const float*)d_in[8];
    p.ret_w_in = (const float*)d_in[9]; p.ret_decay_f = (const float*)d_in[10]; p.ret_decay_b = (const float*)d_in[11]; p.ret_gn_f = (const float*)d_in[12]; p.ret_gn_b = (const float*)d_in[13]; p.ret_w_out = (const float*)d_in[14];
    p.swa_w_qkv = (const float*)d_in[15]; p.swa_sink = (const float*)d_in[16]; p.swa_w_out = (const float*)d_in[17];
    p.moe_router = (const float*)d_in[18]; p.moe_w_gate = (const float*)d_in[19]; p.moe_w_up = (const float*)d_in[20]; p.moe_w_down = (const float*)d_in[21];
    p.out = (float*)d_out; p.ws = (unsigned char*)d_ws;
#if MK_ONE_LAUNCH
    p.ph_lo = 0; p.ph_hi = NPHASE;
    hipLaunchKernelGGL(mega_fwd, dim3(grid), dim3(512), LDS_BYTES, stream, p);
#else
    const int last = (DBG_STOP >= 0) ? DBG_STOP : NPHASE - 1;
    for (int ph = 0; ph <= last; ++ph) { p.ph_lo = ph; p.ph_hi = ph + 1; hipLaunchKernelGGL(mega_fwd, dim3(grid), dim3(512), LDS_BYTES, stream, p); }
    if (DBG_STOP >= 0 && DBG_SRC != 0) hipLaunchKernelGGL(dbg_dump_bf16, dim3(1024), dim3(256), 0, stream, (const bf16_t*)((unsigned char*)d_ws + (size_t)(DBG_SRC)), (size_t)(DBG_N), (size_t)(DBG_MUL), (float*)d_out, (size_t)NLAT * D);
    else if (DBG_STOP >= 0) hipLaunchKernelGGL(dbg_dump, dim3(1024), dim3(256), 0, stream, (const float*)((unsigned char*)d_ws + WS_XR), (float*)d_out, (size_t)NLAT * D);
#endif
}
```

```cpp
#include <hip/hip_runtime.h>
#include <cstdio>
#include <cstdint>

#ifndef MK_ONE_LAUNCH
#define MK_ONE_LAUNCH 1
#endif

#define LAS __attribute__((address_space(3)))
typedef unsigned short bf16_t;
typedef short bf16x8 __attribute__((ext_vector_type(8)));
typedef short s16x4 __attribute__((ext_vector_type(4)));
typedef float f32x4 __attribute__((ext_vector_type(4)));
typedef float f32x2 __attribute__((ext_vector_type(2)));
typedef unsigned u32x4 __attribute__((ext_vector_type(4)));
typedef unsigned u32x2 __attribute__((ext_vector_type(2)));

constexpr int NB = 8, T = 2048, D = 1024, TC = 256;
constexpr int NLAT = NB * T;
constexpr int NCTX = NB * TC;
constexpr int NROW = NLAT + NCTX;
constexpr int NE = 16, FF = 2048;
constexpr int QKG_LD = 6144;
constexpr int QKV_LD = 1280;
constexpr float LOG2E = 1.4426950408889634f;

constexpr size_t MiB = 1u << 20;
constexpr size_t WS_CTL = 0;
constexpr size_t CTL_BYTES = 64 * 1024;
constexpr size_t WS_MOD = 1 * MiB;
constexpr size_t WS_ROPE = 1 * MiB + 512 * 1024;
constexpr size_t WS_WQKG = 2 * MiB;
constexpr size_t WS_WV = 14 * MiB;
constexpr size_t WS_WRO = 18 * MiB;
constexpr size_t WS_WQKV = 22 * MiB;
constexpr size_t WS_WSO = 25 * MiB;
constexpr size_t WS_AFF = 27 * MiB;
constexpr size_t WS_TOK = 29 * MiB;
constexpr size_t WS_GATE = WS_TOK + 36864 * 4;
constexpr size_t WS_INV = WS_GATE + 36864 * 4;
constexpr size_t WS_GNST = 31 * MiB;
constexpr size_t WS_HBUF = 36 * MiB;
constexpr size_t WS_XR = 72 * MiB;
constexpr size_t WS_GU = 144 * MiB;
constexpr size_t WS_DW = 400 * MiB;
constexpr size_t WS_H2 = WS_GU + 128 * MiB;
constexpr size_t WS_R = 528 * MiB;
constexpr size_t WS_END = 960 * MiB;
constexpr size_t R_QKG = WS_R;
constexpr size_t R_VT = WS_R + 216 * MiB;
constexpr size_t R_OF = WS_R + 288 * MiB;
constexpr size_t R_OB = WS_R + 360 * MiB;
constexpr size_t R_XRP = WS_XR + 36 * MiB;
constexpr size_t R_YS2 = WS_R + 288 * MiB;
constexpr size_t R_XS = WS_R;
constexpr size_t R_HID = WS_R + 72 * MiB;
constexpr size_t R_YS = WS_R + 216 * MiB;
constexpr size_t R_QKV = WS_R;
constexpr size_t R_O1 = WS_R + 48 * MiB;

constexpr int LDS_BYTES = 147456;
constexpr int LDS_MISC = 147456 - 64;

typedef __bf16 bf16x2_t __attribute__((ext_vector_type(2)));
__device__ __forceinline__ unsigned cvt_pk_bf16(float lo, float hi) { const f32x2 v = {lo, hi}; const bf16x2_t b = __builtin_convertvector(v, bf16x2_t); return __builtin_bit_cast(unsigned, b); }
__device__ __forceinline__ float bf_lo(unsigned w) { return __uint_as_float(w << 16); }
__device__ __forceinline__ float bf_hi(unsigned w) { return __uint_as_float(w & 0xffff0000u); }
__device__ __forceinline__ float wave_sum(float v) {
#pragma unroll
    for (int o = 1; o < 64; o <<= 1) v += __shfl_xor(v, o);
    return v;
}
__device__ __forceinline__ float sum_x16x32(float x) {
    auto a = __builtin_amdgcn_permlane32_swap(__float_as_uint(x), __float_as_uint(x), false, false); x = __uint_as_float(a[0]) + __uint_as_float(a[1]);
    auto b = __builtin_amdgcn_permlane16_swap(__float_as_uint(x), __float_as_uint(x), false, false); return __uint_as_float(b[0]) + __uint_as_float(b[1]);
}
__device__ __forceinline__ float max_x16x32(float x) {
    auto a = __builtin_amdgcn_permlane32_swap(__float_as_uint(x), __float_as_uint(x), false, false); x = fmaxf(__uint_as_float(a[0]), __uint_as_float(a[1]));
    auto b = __builtin_amdgcn_permlane16_swap(__float_as_uint(x), __float_as_uint(x), false, false); return fmaxf(__uint_as_float(b[0]), __uint_as_float(b[1]));
}
__device__ __forceinline__ u32x4 pair_rows16(u32x2 a, u32x2 b) {
    auto rx = __builtin_amdgcn_permlane16_swap(a.x, b.x, false, false); auto ry = __builtin_amdgcn_permlane16_swap(a.y, b.y, false, false);
    return (u32x4){rx[0], ry[0], rx[1], ry[1]};
}
__device__ __forceinline__ void wg_sync() { asm volatile("s_waitcnt vmcnt(0) lgkmcnt(0)" ::: "memory"); __builtin_amdgcn_s_barrier(); asm volatile("" ::: "memory"); }
__device__ __forceinline__ void wg_sync_lds() { asm volatile("s_waitcnt lgkmcnt(0)" ::: "memory"); __builtin_amdgcn_s_barrier(); asm volatile("" ::: "memory"); }
__device__ __forceinline__ float silu_f(float x) { return x * __builtin_amdgcn_rcpf(1.0f + __builtin_amdgcn_exp2f(-x * LOG2E)); }

constexpr float FP8_SX = 16.0f, FP8_SW = 256.0f, FP8_SH = 8.0f, FP8_SO = 32.0f;
__device__ __forceinline__ float clamp448(float x) { return __builtin_fminf(__builtin_fmaxf(x, -448.0f), 448.0f); }
__device__ __forceinline__ unsigned pk4_fp8(float a, float b, float c, float d) { int w = 0; w = __builtin_amdgcn_cvt_pk_fp8_f32(clamp448(a), clamp448(b), w, false); w = __builtin_amdgcn_cvt_pk_fp8_f32(clamp448(c), clamp448(d), w, true); return (unsigned)w; }
#define XB_TMO      128
#define XB_XCNT(j)  (256  + 64 * (j))
#define XB_XSUB(j)  (1280 + 64 * (j))
#define XB_XGEN(j)  (2304 + 64 * (j))
#define XB_TOP      3328
#define XB_TOPGEN   3392
#define XCD_BAR_WORDS 3456
#define XB_SPIN_CAP (1u << 18)
__device__ __forceinline__ unsigned xb_ld(unsigned* p)              { return __hip_atomic_load(p, __ATOMIC_RELAXED, __HIP_MEMORY_SCOPE_AGENT); }
__device__ __forceinline__ unsigned xb_add(unsigned* p, unsigned v) { return __hip_atomic_fetch_add(p, v, __ATOMIC_RELAXED, __HIP_MEMORY_SCOPE_AGENT); }
__device__ __forceinline__ unsigned xb_xcc_id() { return (unsigned)__builtin_amdgcn_s_getreg((3 << 11) | 20) & 0xFu; }
#define XB_SPIN(cond, bar) do { unsigned _sp = 0; while (cond) { __builtin_amdgcn_s_sleep(1); \
    if ((++_sp & 255u) == 0u) { if (xb_ld(&(bar)[XB_TMO])) break; if (_sp > XB_SPIN_CAP) { atomicAdd(&(bar)[XB_TMO], 1u); break; } } } } while (0)
struct XcdBarrier { unsigned* bar; unsigned x; volatile LAS unsigned* st; };
__device__ __forceinline__ XcdBarrier xcd_barrier_post(unsigned* bar, volatile LAS unsigned* st) {
    XcdBarrier b; b.bar = bar; b.x = xb_xcc_id(); b.st = st;
    if (threadIdx.x == 0) (void)xb_add(&bar[XB_XCNT(b.x)], 1u);
    return b;
}
__device__ __forceinline__ void xcd_barrier_complete(unsigned* bar, unsigned x, unsigned& nloc, unsigned& nx) {
    const unsigned G = gridDim.x * gridDim.y * gridDim.z;
    unsigned sum, cnt, mine, sp = 0u;
    for (;;) {
        sum = 0u; cnt = 0u; mine = 0u;
#pragma unroll
        for (unsigned j = 0; j < 16; ++j) { const unsigned c = xb_ld(&bar[XB_XCNT(j)]); sum += c; cnt += (c > 0u) ? 1u : 0u; mine = (j == x) ? c : mine; }
        if (sum == G) break;
        __builtin_amdgcn_s_sleep(1);
        if ((++sp & 255u) == 0u) { if (xb_ld(&bar[XB_TMO])) break; if (sp > XB_SPIN_CAP) { atomicAdd(&bar[XB_TMO], 1u); break; } }
    }
    nloc = mine > 0u ? mine : 1u; nx = cnt > 0u ? cnt : 1u;
}
__device__ __forceinline__ void xcd_barrier(const XcdBarrier& b) {
    asm volatile("s_waitcnt vmcnt(0)" ::: "memory");
    __syncthreads();
    if (threadIdx.x == 0) {
        unsigned* bar = b.bar;
        __builtin_amdgcn_s_waitcnt(0);
        unsigned nloc = b.st[0], nx = b.st[1];
        if (nloc == 0u) { xcd_barrier_complete(bar, b.x, nloc, nx); b.st[0] = nloc; b.st[1] = nx; }
        const unsigned old = xb_add(&bar[XB_XSUB(b.x)], 1u);
        const unsigned gen = old / nloc;
        if (old + 1u == (gen + 1u) * nloc) {
            __builtin_amdgcn_fence(__ATOMIC_RELEASE, "agent");
            asm volatile("s_waitcnt vmcnt(0)" ::: "memory");
            const unsigned og = xb_add(&bar[XB_TOP], 1u);
            const unsigned tg = og / nx;
            if (og + 1u == (tg + 1u) * nx) xb_add(&bar[XB_TOPGEN], 1u);
            else XB_SPIN(xb_ld(&bar[XB_TOPGEN]) == tg, bar);
            __builtin_amdgcn_fence(__ATOMIC_ACQUIRE, "agent");
            xb_add(&bar[XB_XGEN(b.x)], 1u);
            asm volatile("s_waitcnt vmcnt(0)" ::: "memory");
        } else {
            XB_SPIN(xb_ld(&bar[XB_XGEN(b.x)]) == gen, bar);
            __builtin_amdgcn_fence(__ATOMIC_ACQUIRE, "agent");
            asm volatile("s_waitcnt vmcnt(0)" ::: "memory");
        }
    }
    __syncthreads();
}

#define GB_XTAB   8448
#define GB_CTR(g) (8704 + 64 * (g))
__device__ __forceinline__ void grp_barrier(unsigned* bar, volatile LAS unsigned* st) {
    asm volatile("s_waitcnt vmcnt(0)" ::: "memory");
    __syncthreads();
    if (threadIdx.x == 0) {
        const unsigned g = blockIdx.x & 7u, nmem = gridDim.x >> 3;
        __builtin_amdgcn_s_waitcnt(0);
        unsigned loc = st[2];
        if (loc == 0u) { const unsigned mine = xb_xcc_id() + 1u; unsigned ok = 1u;
            for (unsigned k = 0; k < nmem; ++k) ok &= (xb_ld(&bar[GB_XTAB + g + 8u * k]) == mine) ? 1u : 0u;
            loc = ok ? 1u : 2u; st[2] = loc; }
        if (loc == 2u) { __builtin_amdgcn_fence(__ATOMIC_RELEASE, "agent"); asm volatile("s_waitcnt vmcnt(0)" ::: "memory"); }
        const unsigned n = st[3] + 1u; st[3] = n;
        const unsigned target = n * nmem;
        (void)xb_add(&bar[GB_CTR(g)], 1u);
        XB_SPIN(xb_ld(&bar[GB_CTR(g)]) < target, bar);
        __builtin_amdgcn_fence(__ATOMIC_ACQUIRE, "agent");
        asm volatile("s_waitcnt vmcnt(0)" ::: "memory");
    }
    __syncthreads();
}

namespace pg8 {
constexpr int BM = 256, BK = 64, HALF = 128, HTB = HALF * BK * 2, STAGE_BYTES = 8 * HTB;
__device__ __forceinline__ int lds_byte(int r, int c) { const int st = (r >> 4) * 2 + (c >> 5), rr = r & 15, cc = c & 31, ob = rr * 64 + cc * 2; return st * 1024 + (ob ^ (((ob >> 9) & 1) << 5)); }
__device__ __forceinline__ void stage_rc(int b, int& R, int& C) { const int st = b / 1024, sb = b % 1024, swz = sb ^ (((sb >> 9) & 1) << 5); R = (st >> 1) * 16 + swz / 64; C = (st & 1) * 32 + (swz % 64) / 2; }
__device__ __forceinline__ int perm32(int rho) { const int n = rho >> 4, i = rho & 15; return 8 * (i >> 2) + 4 * n + (i & 3); }
struct Unit { int pm, pn, aux; };
struct Gemm { int lda, ldb; };
__device__ __forceinline__ void tile_order(int wgid, int nM, int nN, int& pm, int& pn) {
    const int nwg = nM * nN;
    { const int q = nwg / 8, r = nwg % 8, xcd = wgid % 8, off = wgid / 8; wgid = (xcd < r ? xcd * (q + 1) : r * (q + 1) + (xcd - r) * q) + off; }
    const int nig = 8 * nN, gid = wgid / nig, fm = gid * 8, gsz = (nM - fm) < 8 ? (nM - fm) : 8;
    pm = fm + ((wgid % nig) % gsz); pn = (wgid % nig) / gsz;
}
typedef int v4i_t __attribute__((ext_vector_type(4)));
typedef int v8i_t __attribute__((ext_vector_type(8)));
__device__ __forceinline__ v8i_t cat_frag(bf16x8 a, bf16x8 b) { return __builtin_shufflevector(__builtin_bit_cast(v4i_t, a), __builtin_bit_cast(v4i_t, b), 0, 1, 2, 3, 4, 5, 6, 7); }
template <class Epi, class Sched, bool FP8 = false>
__device__ __forceinline__ void gemm_phase(LAS unsigned char* lds, const Gemm g, const Sched& S, const Epi& E) {
    const int tid = threadIdx.x, wid = __builtin_amdgcn_readfirstlane(tid >> 6), lane = tid & 63, wr = wid >> 2, wc = wid & 3, fr = lane & 15, fq = lane >> 4;
    unsigned voffA[2], voffB[2];
#pragma unroll
    for (int i = 0; i < 2; ++i) { int R, C; stage_rc(tid * 16 + i * 8192, R, C); const int Rb = Epi::PERM ? ((R & ~31) + perm32(R & 31)) : R;
        voffA[i] = (unsigned)(R * g.lda + C) * 2u; voffB[i] = (unsigned)(Rb * g.ldb + C) * 2u; }
    const size_t kstep = (size_t)(BK * 2);
    const size_t hstepA = (size_t)HALF * g.lda * 2, hstepB = (size_t)HALF * g.ldb * 2;
    const unsigned ldsw = (unsigned)wid * 1024u;
    const int aoff = lds_byte(wr * 64 + fr, fq * 8), boff = lds_byte(wc * 32 + fr, fq * 8);
#define PG8_SA(b, h) (((b) * 2 + (h)) * HTB)
#define PG8_SB(b, h) ((4 + (b) * 2 + (h)) * HTB)
#define PG8_STAGE(bufoff, gbase, voff) do { _Pragma("unroll") for (int _i = 0; _i < 2; ++_i) \
        __builtin_amdgcn_global_load_lds((const unsigned*)((const char*)(gbase) + (voff)[_i]), (LAS unsigned*)(lds + (bufoff) + ldsw + _i * 8192), 16, 0, 0); } while (0)
#define PG8_LDA8(m_, slot_) cat_frag(*(const LAS bf16x8*)(lds + (slot_) + (m_) * 2048), *(const LAS bf16x8*)(lds + (slot_) + (m_) * 2048 + 1024))
#define PG8_LDA(dst, b, h) do { if constexpr (FP8) { a_slot = PG8_SA(b, h) + aoff; dst##8[0] = PG8_LDA8(0, a_slot); dst##8[1] = PG8_LDA8(1, a_slot); } \
        else { _Pragma("unroll") for (int m = 0; m < 4; ++m) _Pragma("unroll") for (int k = 0; k < 2; ++k) dst[m][k] = *(const LAS bf16x8*)(lds + PG8_SA(b, h) + aoff + m * 2048 + k * 1024); } } while (0)
#define PG8_LDB(dst, b, h) do { if constexpr (FP8) { _Pragma("unroll") for (int n = 0; n < 2; ++n) dst##8[n] = cat_frag(*(const LAS bf16x8*)(lds + PG8_SB(b, h) + boff + n * 2048), *(const LAS bf16x8*)(lds + PG8_SB(b, h) + boff + n * 2048 + 1024)); } \
        else { _Pragma("unroll") for (int n = 0; n < 2; ++n) _Pragma("unroll") for (int k = 0; k < 2; ++k) dst[n][k] = *(const LAS bf16x8*)(lds + PG8_SB(b, h) + boff + n * 2048 + k * 1024); } } while (0)
#define PG8_MMA(ai, bj, At, Bt) do { __builtin_amdgcn_s_setprio(1); \
        { _Pragma("unroll") for (int m = 0; m < 4; ++m) _Pragma("unroll") for (int n = 0; n < 2; ++n) _Pragma("unroll") for (int k = 0; k < 2; ++k) \
            acc[ai][bj][m][n] = __builtin_amdgcn_mfma_f32_16x16x32_bf16(Bt[n][k], At[m][k], acc[ai][bj][m][n], 0, 0, 0); } \
        __builtin_amdgcn_s_setprio(0); } while (0)
#define PG8_FMA8(accv, Bv, Av) asm volatile("v_mfma_scale_f32_16x16x128_f8f6f4 %0, %1, %2, %0, %3, %3 op_sel_hi:[0,0,0]" : "+v"(accv) : "v"(Bv), "v"(Av), "v"(one8))
#define PG8_MMA8(ai, mm, Ar) do { _Pragma("unroll") for (int n = 0; n < 2; ++n) PG8_FMA8(acc[ai][0][mm][n], B08[n], Ar); \
        _Pragma("unroll") for (int n = 0; n < 2; ++n) PG8_FMA8(acc[ai][1][mm][n], B18[n], Ar); } while (0)
#define PG8_MMAP(ai) do { if constexpr (FP8) { __builtin_amdgcn_s_setprio(1); PG8_MMA8(ai, 0, At8[0]); PG8_SCHED; At8[0] = PG8_LDA8(2, a_slot); PG8_SCHED; PG8_MMA8(ai, 1, At8[1]); PG8_SCHED; At8[1] = PG8_LDA8(3, a_slot); PG8_SCHED; \
            PG8_MMA8(ai, 2, At8[0]); PG8_MMA8(ai, 3, At8[1]); __builtin_amdgcn_s_setprio(0); } \
        else { PG8_MMA(ai, 0, At, B0); PG8_MMA(ai, 1, At, B1); } } while (0)
#define PG8_WAIT_V(n) asm volatile("s_waitcnt vmcnt(" #n ")" ::: "memory")
#define PG8_WAIT_L(n) asm volatile("s_waitcnt lgkmcnt(" #n ")" ::: "memory")
#define PG8_BAR __builtin_amdgcn_s_barrier()
#define PG8_SCHED __builtin_amdgcn_sched_barrier(0)
    Unit cur, nxt; int ui = 0;
    if (!S.next(0, cur)) return;
    f32x4 acc[2][2][4][2];
#pragma unroll
    for (int a = 0; a < 2; ++a)
#pragma unroll
        for (int b = 0; b < 2; ++b)
#pragma unroll
            for (int m = 0; m < 4; ++m)
#pragma unroll
                for (int n = 0; n < 2; ++n) acc[a][b][m][n] = (f32x4){0.f, 0.f, 0.f, 0.f};
    bf16x8 At[4][2], B0[2][2], B1[2][2];
    v8i_t At8[2], B08[2], B18[2]; int a_slot = 0; const int one8 = 0x7F7F7F7F;
    const char* cA = S.aptr(cur); const char* cB = S.bptr(cur); int nt = S.nt(cur);
    PG8_STAGE(PG8_SB(0, 0), cB, voffB); PG8_STAGE(PG8_SB(0, 1), cB + hstepB, voffB); PG8_STAGE(PG8_SA(0, 0), cA, voffA); PG8_STAGE(PG8_SA(0, 1), cA + hstepA, voffA);
    if (wr == 1) PG8_BAR;
    PG8_WAIT_V(2); PG8_BAR;
    PG8_STAGE(PG8_SB(1, 0), cB + kstep, voffB); PG8_STAGE(PG8_SA(1, 0), cA + kstep, voffA); PG8_STAGE(PG8_SB(1, 1), cB + hstepB + kstep, voffB);
    PG8_WAIT_V(6); PG8_BAR;
    for (;;) {
        const bool has_next = S.next(ui + 1, nxt);
        const char* nA = has_next ? S.aptr(nxt) : cA; const char* nB = has_next ? S.bptr(nxt) : cB;
        for (int t = 0; t < nt; t += 2) {
            const bool last = (t == nt - 2);
            const char* a1 = cA + (size_t)(t + 1) * kstep;
            const char* a2 = last ? nA : cA + (size_t)(t + 2) * kstep; const char* b2 = last ? nB : cB + (size_t)(t + 2) * kstep;
            const char* a3 = a2 + kstep; const char* b3 = b2 + kstep;
            PG8_LDB(B0, 0, 0); PG8_LDB(B1, 0, 1); PG8_SCHED; PG8_LDA(At, 0, 0); PG8_STAGE(PG8_SA(1, 1), a1 + hstepA, voffA);
            PG8_WAIT_V(8); PG8_WAIT_L(0); PG8_BAR; PG8_MMAP(0); PG8_BAR; PG8_SCHED;
            PG8_LDA(At, 0, 1); PG8_STAGE(PG8_SB(0, 0), b2, voffB); PG8_STAGE(PG8_SB(0, 1), b2 + hstepB, voffB); PG8_STAGE(PG8_SA(0, 0), a2, voffA);
            PG8_WAIT_V(8); PG8_WAIT_L(0); PG8_BAR; PG8_MMAP(1); PG8_BAR; PG8_SCHED;
            PG8_LDB(B0, 1, 0); PG8_LDB(B1, 1, 1); PG8_SCHED; PG8_LDA(At, 1, 0); PG8_STAGE(PG8_SA(0, 1), a2 + hstepA, voffA);
            PG8_WAIT_V(8); PG8_WAIT_L(0); PG8_BAR; PG8_MMAP(0); PG8_BAR; PG8_SCHED;
            PG8_LDA(At, 1, 1); PG8_STAGE(PG8_SB(1, 0), b3, voffB); PG8_STAGE(PG8_SB(1, 1), b3 + hstepB, voffB); PG8_STAGE(PG8_SA(1, 0), a3, voffA);
            PG8_WAIT_V(8); PG8_WAIT_L(0); PG8_BAR; PG8_MMAP(1); PG8_BAR; PG8_SCHED;
        }
        if (wr == 0) PG8_BAR;
        if constexpr (FP8) asm volatile("s_nop 15\n\ts_nop 15" ::: "memory");
        E(acc, cur, wr, wc, fr, fq);
        if (!has_next) break;
#pragma unroll
        for (int a = 0; a < 2; ++a)
#pragma unroll
            for (int b = 0; b < 2; ++b)
#pragma unroll
                for (int m = 0; m < 4; ++m)
#pragma unroll
                    for (int n = 0; n < 2; ++n) acc[a][b][m][n] = (f32x4){0.f, 0.f, 0.f, 0.f};
        cur = nxt; cA = nA; cB = nB; nt = S.nt(cur); ++ui;
        if (wr == 1) PG8_BAR;
    }
    PG8_WAIT_V(0);
    PG8_BAR;
#undef PG8_SA
#undef PG8_SB
#undef PG8_STAGE
#undef PG8_LDA
#undef PG8_LDB
#undef PG8_MMA
#undef PG8_MMA8
#undef PG8_FMA8
#undef PG8_MMAP
#undef PG8_LDA8
#undef PG8_WAIT_V
#undef PG8_WAIT_L
#undef PG8_BAR
#undef PG8_SCHED
}
}

struct Params {
    const float* x; const float* c; const float* ctx; const float* c_ctx; const float* ada_w; const float* ada_b;
    const float* norm1_g; const float* norm2_g; const float* final_g;
    const float* ret_w_in; const float* ret_decay_f; const float* ret_decay_b; const float* ret_gn_f; const float* ret_gn_b; const float* ret_w_out;
    const float* swa_w_qkv; const float* swa_sink; const float* swa_w_out;
    const float* moe_router; const float* moe_w_gate; const float* moe_w_up; const float* moe_w_down;
    float* out; unsigned char* ws;
    int ph_lo, ph_hi;
};
#define WSP(T_, off) ((T_*)(P.ws + (off)))

struct SchedIn {
    const bf16_t* H; const bf16_t* Wqkg; const bf16_t* Wv; int ng, x, kx;
    __device__ __forceinline__ bool next(int i, pg8::Unit& u) const {
        const int li = i * ng + kx; if (li >= 288) return false;
        if (li < 216) { const int mi = li % 9; u.pm = mi < 8 ? 8 * x + mi : 64 + x; u.pn = li / 9; u.aux = 0; }
        else { const int q = li - 216, ri = q >> 3; u.pm = q & 7; u.pn = ri < 8 ? 8 * x + ri : 64 + x; u.aux = 1; }
        return true;
    }
    __device__ __forceinline__ int nt(const pg8::Unit&) const { return 16; }
    __device__ __forceinline__ const char* aptr(const pg8::Unit& u) const { return (const char*)((u.aux ? Wv : H) + (size_t)u.pm * 256 * 1024); }
    __device__ __forceinline__ const char* bptr(const pg8::Unit& u) const { return (const char*)((u.aux ? H : Wqkg) + (size_t)u.pm * 0 + (size_t)u.pn * 256 * 1024); }
};
struct SchedPlain {
    const bf16_t* A; const bf16_t* B; int lda, ldb, nM, nN, G, c;
    __device__ __forceinline__ int nt(const pg8::Unit&) const { return lda >> 6; }
    __device__ __forceinline__ bool next(int i, pg8::Unit& u) const {
        const int L = i * G + c; if (L >= nM * nN) return false;
        pg8::tile_order(L, nM, nN, u.pm, u.pn); u.aux = -1; return true;
    }
    __device__ __forceinline__ const char* aptr(const pg8::Unit& u) const { return (const char*)(A + (size_t)u.pm * 256 * lda); }
    __device__ __forceinline__ const char* bptr(const pg8::Unit& u) const { return (const char*)(B + (size_t)u.pn * 256 * ldb); }
};
struct SchedQkv {
    const bf16_t* A; const bf16_t* B; int G, c;
    __device__ __forceinline__ int nt(const pg8::Unit&) const { return 8; }
    __device__ __forceinline__ bool next(int i, pg8::Unit& u) const {
        const int L = i * G + c; if (L >= 328) return false;
        if (L < 320) { pg8::tile_order(L, 64, 5, u.pm, u.pn); } else { u.pm = 64 + (L - 320); u.pn = 4; }
        u.aux = 0; return true;
    }
    __device__ __forceinline__ const char* aptr(const pg8::Unit& u) const { return (const char*)A + (size_t)u.pm * 256 * 1024; }
    __device__ __forceinline__ const char* bptr(const pg8::Unit& u) const { return (const char*)B + (size_t)u.pn * 256 * 1024; }
};
struct SchedGrouped {
    const bf16_t* A; const bf16_t* B; int lda, ldb, nMe, nNe, G, c;
    __device__ __forceinline__ int nt(const pg8::Unit&) const { return lda >> 6; }
    __device__ __forceinline__ bool next(int i, pg8::Unit& u) const {
        const int upe = nMe * nNe, spx = G >> 3, idx = i * spx + (c >> 3); if (idx >= 2 * upe) return false;
        const int e = (c & 7) + 8 * (idx / upe), r = idx % upe, gw = nNe < 8 ? nNe : 8;
        const int gcol = r / (nMe * gw), rr = r - gcol * nMe * gw, pml = rr / gw, pnl = gcol * gw + rr % gw;
        u.pm = e * nMe + pml; u.pn = e * nNe + pnl; u.aux = pnl; return true;
    }
    __device__ __forceinline__ const char* aptr(const pg8::Unit& u) const { return (const char*)(A + (size_t)u.pm * 256 * lda); }
    __device__ __forceinline__ const char* bptr(const pg8::Unit& u) const { return (const char*)(B + (size_t)u.pn * 256 * ldb); }
};

struct SchedRO {
    const bf16_t* A; const bf16_t* B; int G, c;
    __device__ __forceinline__ bool next(int i, pg8::Unit& u) const {
        const int L = i * G + c; if (L >= 384) return false;
        if (L < 256) { pg8::tile_order(L, 64, 4, u.pm, u.pn); u.aux = -1; } else { const int j = L - 256, r = j >> 3; u.pm = 64 + (j & 7); u.pn = r & 3; u.aux = r >> 2; }
        return true;
    }
    __device__ __forceinline__ int nt(const pg8::Unit& u) const { return u.aux < 0 ? 32 : 8; }
    __device__ __forceinline__ const char* aptr(const pg8::Unit& u) const { return (const char*)(A + (size_t)u.pm * 256 * 2048 + (u.aux < 0 ? 0 : u.aux * 512)); }
    __device__ __forceinline__ const char* bptr(const pg8::Unit& u) const { return (const char*)(B + (size_t)u.pn * 256 * 2048 + (u.aux < 0 ? 0 : u.aux * 512)); }
};
struct SchedDown0 {
    const bf16_t* A; const bf16_t* B; int G, c, ld;
    __device__ __forceinline__ bool next(int i, pg8::Unit& u) const {
        const int spx = G >> 3, idx = i * spx + (c >> 3); if (idx >= 96) return false;
        if (idx < 64) { const int e = (c & 7) + 8 * (idx >> 5), r = idx & 31; u.pm = e * 9 + (r >> 2); u.pn = e * 4 + (r & 3); u.aux = r & 3; }
        else { const int q = idx - 64, e = (c & 7) + 8 * (q >> 4), qq = q & 15, pnl = qq >> 2, sl = qq & 3; u.pm = e * 9 + 8; u.pn = e * 4 + pnl; u.aux = pnl + 4 * (sl + 1); }
        return true;
    }
    __device__ __forceinline__ int nt(const pg8::Unit& u) const { return u.aux < 4 ? (ld >> 6) : (ld >> 8); }
    __device__ __forceinline__ const char* aptr(const pg8::Unit& u) const { return (const char*)(A + (size_t)u.pm * 256 * ld + (u.aux < 4 ? 0 : ((u.aux >> 2) - 1) * (ld >> 2))); }
    __device__ __forceinline__ const char* bptr(const pg8::Unit& u) const { return (const char*)(B + (size_t)u.pn * 256 * ld + (u.aux < 4 ? 0 : ((u.aux >> 2) - 1) * (ld >> 2))); }
};

struct EpiIn {
    static constexpr bool PERM = true;
    bf16_t* QKG; bf16_t* VT;
    __device__ __forceinline__ void operator()(const f32x4 (&acc)[2][2][4][2], const pg8::Unit& u, int wr, int wc, int fr, int fq) const {
        bf16_t* base = u.aux ? VT : QKG; const size_t ld = u.aux ? (size_t)NROW : (size_t)QKG_LD;
        const int row0 = u.pm * 256 + wr * 64 + fr, col0 = u.pn * 256 + wc * 32 + 8 * fq;
#pragma unroll
        for (int ai = 0; ai < 2; ++ai)
#pragma unroll
            for (int m = 0; m < 4; ++m) { bf16_t* rowp = base + (size_t)(row0 + ai * 128 + m * 16) * ld + col0;
#pragma unroll
                for (int bj = 0; bj < 2; ++bj) { const f32x4 v0 = acc[ai][bj][m][0], v1 = acc[ai][bj][m][1];
                    u32x4 w; w.x = cvt_pk_bf16(v0[0], v0[1]); w.y = cvt_pk_bf16(v0[2], v0[3]); w.z = cvt_pk_bf16(v1[0], v1[1]); w.w = cvt_pk_bf16(v1[2], v1[3]);
                    *(u32x4*)(rowp + bj * 128) = w; } }
    }
};
struct EpiRes {
    static constexpr bool PERM = false;
    const float* rl; const float* rc; const bf16_t* rb; const float* gate; bf16_t* out; float* slab; float dsc;
    __device__ __forceinline__ void operator()(const f32x4 (&acc)[2][2][4][2], const pg8::Unit& u, int wr, int wc, int fr, int fq) const {
        const int rowt = u.pm * 256; const int ci = rowt < NLAT ? rowt / T : 8;
        const float* rbase = rowt < NLAT ? rl : rc - (size_t)NLAT * D;
        if (u.aux >= 0) {
            float* ob = slab + ((size_t)u.aux * NCTX - NLAT) * D;
            const int row0 = rowt + wr * 64 + fr, col0 = u.pn * 256 + wc * 32 + 4 * fq;
            f32x4 gs[2][2];
#pragma unroll
            for (int bj = 0; bj < 2; ++bj)
#pragma unroll
                for (int n = 0; n < 2; ++n) gs[bj][n] = *(const f32x4*)(gate + (size_t)ci * 6144 + col0 + bj * 128 + n * 16);
            if (u.aux != 0) {
#pragma unroll
                for (int ai = 0; ai < 2; ++ai)
#pragma unroll
                    for (int m = 0; m < 4; ++m) { const size_t off = (size_t)(row0 + ai * 128 + m * 16) * D + col0;
#pragma unroll
                        for (int bj = 0; bj < 2; ++bj)
#pragma unroll
                            for (int n = 0; n < 2; ++n) *(f32x4*)(ob + off + bj * 128 + n * 16) = gs[bj][n] * acc[ai][bj][m][n]; }
            } else {
                f32x4 rr[2][2][2];
#pragma unroll
                for (int bj = 0; bj < 2; ++bj)
#pragma unroll
                    for (int n = 0; n < 2; ++n) rr[0][bj][n] = *(const f32x4*)(rbase + (size_t)row0 * D + col0 + bj * 128 + n * 16);
#pragma unroll
                for (int gi = 0; gi < 8; ++gi) { const int ai = gi >> 2, m = gi & 3; const size_t off = (size_t)(row0 + ai * 128 + m * 16) * D + col0;
                    if (gi + 1 < 8) { const size_t off2 = (size_t)(row0 + ((gi + 1) >> 2) * 128 + ((gi + 1) & 3) * 16) * D + col0;
#pragma unroll
                        for (int bj = 0; bj < 2; ++bj)
#pragma unroll
                            for (int n = 0; n < 2; ++n) rr[(gi + 1) & 1][bj][n] = *(const f32x4*)(rbase + off2 + bj * 128 + n * 16); }
#pragma unroll
                    for (int bj = 0; bj < 2; ++bj)
#pragma unroll
                        for (int n = 0; n < 2; ++n) *(f32x4*)(ob + off + bj * 128 + n * 16) = gs[bj][n] * acc[ai][bj][m][n] + rr[gi & 1][bj][n];
                    __builtin_amdgcn_sched_barrier(0); }
            }
            return;
        }
        const int row0 = rowt + wr * 64 + fr, col0 = u.pn * 256 + wc * 32 + 4 * fq;
        f32x4 gv[2][2];
#pragma unroll
        for (int bj = 0; bj < 2; ++bj)
#pragma unroll
            for (int n = 0; n < 2; ++n) gv[bj][n] = *(const f32x4*)(gate + (size_t)ci * 6144 + col0 + bj * 128 + n * 16) * dsc;
        const int coloff = 8 * (fq >> 1) - 4 * fq;
        if (rb) {
            u32x2 rq[4][2][2];
#pragma unroll
            for (int g0 = 0; g0 < 2; ++g0) { const size_t off = (size_t)(row0 + (g0 >> 2) * 128 + (g0 & 3) * 16) * D + col0;
#pragma unroll
                for (int bj = 0; bj < 2; ++bj)
#pragma unroll
                    for (int n = 0; n < 2; ++n) rq[g0][bj][n] = *(const u32x2*)(rb + off + bj * 128 + n * 16); }
#pragma unroll
            for (int gp = 0; gp < 4; ++gp) {
                if (gp < 3) {
#pragma unroll
                    for (int g2 = 2 * gp + 2; g2 < 2 * gp + 4; ++g2) { const size_t off2 = (size_t)(row0 + (g2 >> 2) * 128 + (g2 & 3) * 16) * D + col0;
#pragma unroll
                        for (int bj = 0; bj < 2; ++bj)
#pragma unroll
                            for (int n = 0; n < 2; ++n) rq[g2 & 3][bj][n] = *(const u32x2*)(rb + off2 + bj * 128 + n * 16); } }
                const int gA = 2 * gp, ai = gA >> 2, m = gA & 3;
                const size_t offs = (size_t)(row0 + ai * 128 + (m + (fq & 1)) * 16) * D + col0 + coloff;
#pragma unroll
                for (int bj = 0; bj < 2; ++bj)
#pragma unroll
                    for (int n = 0; n < 2; ++n) { u32x2 wq[2];
#pragma unroll
                        for (int mi = 0; mi < 2; ++mi) { const u32x2 w = rq[(gA + mi) & 3][bj][n]; const f32x4 r = {bf_lo(w.x), bf_hi(w.x), bf_lo(w.y), bf_hi(w.y)};
                            const f32x4 o = r + gv[bj][n] * acc[ai][bj][m + mi][n]; wq[mi].x = cvt_pk_bf16(o[0], o[1]); wq[mi].y = cvt_pk_bf16(o[2], o[3]); }
                        *(u32x4*)(out + offs + bj * 128 + n * 16) = pair_rows16(wq[0], wq[1]); }
                __builtin_amdgcn_sched_barrier(0); }
        } else {
            f32x4 rq[4][2][2];
#pragma unroll
            for (int g0 = 0; g0 < 2; ++g0) { const size_t off = (size_t)(row0 + (g0 >> 2) * 128 + (g0 & 3) * 16) * D + col0;
#pragma unroll
                for (int bj = 0; bj < 2; ++bj)
#pragma unroll
                    for (int n = 0; n < 2; ++n) rq[g0][bj][n] = *(const f32x4*)(rbase + off + bj * 128 + n * 16); }
#pragma unroll
            for (int gp = 0; gp < 4; ++gp) {
                if (gp < 3) {
#pragma unroll
                    for (int g2 = 2 * gp + 2; g2 < 2 * gp + 4; ++g2) { const size_t off2 = (size_t)(row0 + (g2 >> 2) * 128 + (g2 & 3) * 16) * D + col0;
#pragma unroll
                        for (int bj = 0; bj < 2; ++bj)
#pragma unroll
                            for (int n = 0; n < 2; ++n) rq[g2 & 3][bj][n] = *(const f32x4*)(rbase + off2 + bj * 128 + n * 16); } }
                const int gA = 2 * gp, ai = gA >> 2, m = gA & 3;
                const size_t offs = (size_t)(row0 + ai * 128 + (m + (fq & 1)) * 16) * D + col0 + coloff;
#pragma unroll
                for (int bj = 0; bj < 2; ++bj)
#pragma unroll
                    for (int n = 0; n < 2; ++n) { u32x2 wq[2];
#pragma unroll
                        for (int mi = 0; mi < 2; ++mi) { const f32x4 o = rq[(gA + mi) & 3][bj][n] + gv[bj][n] * acc[ai][bj][m + mi][n]; wq[mi].x = cvt_pk_bf16(o[0], o[1]); wq[mi].y = cvt_pk_bf16(o[2], o[3]); }
                        *(u32x4*)(out + offs + bj * 128 + n * 16) = pair_rows16(wq[0], wq[1]); }
                __builtin_amdgcn_sched_barrier(0); }
        }
    }
};
struct EpiGU {
    static constexpr bool PERM = true;
    bf16_t* HID; int fp8;
    __device__ __forceinline__ void operator()(const f32x4 (&acc)[2][2][4][2], const pg8::Unit& u, int wr, int wc, int fr, int fq) const {
        const int row0 = u.pm * 256 + wr * 64 + fr, col0 = u.aux * 128 + wc * 32 + 8 * fq;
        if (fp8) {
            constexpr float dsc = 1.0f / (FP8_SX * FP8_SW);
            const int colw = u.aux * 128 + wc * 32 + 16 * (fq >> 1);
#pragma unroll
            for (int ai = 0; ai < 2; ++ai)
#pragma unroll
                for (int mp = 0; mp < 2; ++mp) { u32x2 wq[2];
#pragma unroll
                    for (int mi = 0; mi < 2; ++mi) { const int m = 2 * mp + mi;
                        f32x4 hq[2];
#pragma unroll
                        for (int n = 0; n < 2; ++n) { const f32x4 ga = acc[ai][0][m][n], t = ga * (-dsc * LOG2E), p = (ga * acc[ai][1][m][n]) * (dsc * dsc * FP8_SH); f32x4 r;
#pragma unroll
                            for (int e = 0; e < 4; ++e) r[e] = __builtin_amdgcn_rcpf(1.0f + __builtin_amdgcn_exp2f(t[e]));
                            hq[n] = p * r; }
                        wq[mi].x = pk4_fp8(hq[0][0], hq[0][1], hq[0][2], hq[0][3]); wq[mi].y = pk4_fp8(hq[1][0], hq[1][1], hq[1][2], hq[1][3]); }
                    const u32x4 o = pair_rows16(wq[0], wq[1]);
                    *(u32x4*)((unsigned char*)HID + (size_t)(row0 + ai * 128 + (2 * mp + (fq & 1)) * 16) * FF + colw) = o; }
            return;
        }
#pragma unroll
        for (int ai = 0; ai < 2; ++ai)
#pragma unroll
            for (int m = 0; m < 4; ++m) {
                float h[8];
#pragma unroll
                for (int n = 0; n < 2; ++n)
#pragma unroll
                    for (int e = 0; e < 4; ++e) h[n * 4 + e] = silu_f(acc[ai][0][m][n][e]) * acc[ai][1][m][n][e];
                u32x4 w; w.x = cvt_pk_bf16(h[0], h[1]); w.y = cvt_pk_bf16(h[2], h[3]); w.z = cvt_pk_bf16(h[4], h[5]); w.w = cvt_pk_bf16(h[6], h[7]);
                *(u32x4*)(HID + (size_t)(row0 + ai * 128 + m * 16) * FF + col0) = w; }
    }
};
struct EpiDown {
    static constexpr bool PERM = true;
    bf16_t* YS; const float* GATE; bf16_t* YS2; float dsc;
    __device__ __forceinline__ void operator()(const f32x4 (&acc)[2][2][4][2], const pg8::Unit& u, int wr, int wc, int fr, int fq) const {
        const int row0 = u.pm * 256 + wr * 64 + fr, col0 = (u.aux & 3) * 256 + wc * 32 + 8 * fq;
        if (u.aux >= 8) {
            const int e = u.pm / 9, sl = (u.aux >> 2) - 1; bf16_t* ob = YS2 + ((size_t)(sl - 1) * 4096 + e * 256) * D;
            float gts[8];
#pragma unroll
            for (int gi = 0; gi < 8; ++gi) gts[gi] = GATE[u.pm * 256 + wr * 64 + fr + (gi >> 2) * 128 + (gi & 3) * 16];
#pragma unroll
            for (int ai = 0; ai < 2; ++ai)
#pragma unroll
                for (int m = 0; m < 4; ++m) { const int rl_ = wr * 64 + fr + ai * 128 + m * 16; const float gt = gts[ai * 4 + m] * dsc;
#pragma unroll
                    for (int bj = 0; bj < 2; ++bj) { const f32x4 v0 = acc[ai][bj][m][0] * gt, v1 = acc[ai][bj][m][1] * gt;
                        u32x4 w; w.x = cvt_pk_bf16(v0[0], v0[1]); w.y = cvt_pk_bf16(v0[2], v0[3]); w.z = cvt_pk_bf16(v1[0], v1[1]); w.w = cvt_pk_bf16(v1[2], v1[3]);
                        *(u32x4*)(ob + (size_t)rl_ * D + col0 + bj * 128) = w; } }
            return;
        }
        const int colw = (u.aux & 3) * 256 + wc * 32 + 16 * (fq >> 1);
        float gtm[8];
#pragma unroll
        for (int gi = 0; gi < 8; ++gi) gtm[gi] = GATE[row0 + (gi >> 2) * 128 + (gi & 3) * 16];
#pragma unroll
        for (int ai = 0; ai < 2; ++ai)
#pragma unroll
            for (int mp = 0; mp < 2; ++mp) { const int rowp = row0 + ai * 128 + 2 * mp * 16; const float gt0 = gtm[ai * 4 + 2 * mp] * (dsc * FP8_SO), gt1 = gtm[ai * 4 + 2 * mp + 1] * (dsc * FP8_SO);
#pragma unroll
                for (int bj = 0; bj < 2; ++bj) { u32x2 wq[2];
#pragma unroll
                    for (int mi = 0; mi < 2; ++mi) { const float gt = mi ? gt1 : gt0; const f32x4 v0 = acc[ai][bj][2 * mp + mi][0] * gt, v1 = acc[ai][bj][2 * mp + mi][1] * gt;
                        wq[mi].x = pk4_fp8(v0[0], v0[1], v0[2], v0[3]); wq[mi].y = pk4_fp8(v1[0], v1[1], v1[2], v1[3]); }
                    *(u32x4*)((unsigned char*)YS + (size_t)(rowp + (fq & 1) * 16) * D + colw + bj * 128) = pair_rows16(wq[0], wq[1]); } }
    }
};
struct EpiQkv {
    static constexpr bool PERM = true;
    bf16_t* O; const float* rope; float dsc;
    __device__ __forceinline__ void operator()(const f32x4 (&acc)[2][2][4][2], const pg8::Unit& u, int wr, int wc, int fr, int fq) const {
        const int rowt = u.pm * 256; const bool lat = rowt < NLAT;
        const int row0 = rowt + wr * 64 + fr, col0 = u.pn * 256 + wc * 32 + 8 * fq;
        f32x4 csq[8][2];
#pragma unroll
        for (int gi = 0; gi < 8; ++gi) { const int t = (row0 + (gi >> 2) * 128 + (gi & 3) * 16) & (T - 1); const int pos = (wc & 1) ? (t & 63) : (t >> 6);
            csq[gi][0] = *(const f32x4*)(rope + (size_t)(pos * 16 + 4 * fq) * 2); csq[gi][1] = *(const f32x4*)(rope + (size_t)(pos * 16 + 4 * fq) * 2 + 4); }
#pragma unroll
        for (int ai = 0; ai < 2; ++ai)
#pragma unroll
            for (int m = 0; m < 4; ++m) { const int row = row0 + ai * 128 + m * 16;
                const f32x4 cs0 = csq[ai * 4 + m][0], cs1 = csq[ai * 4 + m][1];
                const float cc[4] = {cs0[0], cs0[2], cs1[0], cs1[2]}, ss[4] = {cs0[1], cs0[3], cs1[1], cs1[3]};
#pragma unroll
                for (int bj = 0; bj < 2; ++bj) { f32x4 v0 = acc[ai][bj][m][0] * dsc, v1 = acc[ai][bj][m][1] * dsc;
                    const bool dorope = lat && (u.pn < 4 || bj == 0);
                    if (dorope) {
#pragma unroll
                        for (int e = 0; e < 4; ++e) { const float a = v0[e], b = v1[e]; v0[e] = a * cc[e] - b * ss[e]; v1[e] = b * cc[e] + a * ss[e]; } }
                    u32x4 w; w.x = cvt_pk_bf16(v0[0], v0[1]); w.y = cvt_pk_bf16(v0[2], v0[3]); w.z = cvt_pk_bf16(v1[0], v1[1]); w.w = cvt_pk_bf16(v1[2], v1[3]);
                    *(u32x4*)(O + (size_t)row * QKV_LD + col0 + bj * 128) = w; } }
    }
};

__device__ __forceinline__ int rope_perm(int s) { return s < 16 ? ((s >> 2) * 8 + (s & 3)) : (((s - 16) >> 2) * 8 + 4 + (s & 3)); }
__device__ __forceinline__ void transpose_item(const float* W, int ldw, int k0, int n0, bf16_t* WT, int ldt, int drow0, bool rperm, float scale, LAS float* scr, int lane) {
    { float tv[32];
#pragma unroll
      for (int i = 0; i < 32; ++i) tv[i] = W[(size_t)(k0 + 2 * i + (lane >> 5)) * ldw + n0 + (lane & 31)];
#pragma unroll
      for (int i = 0; i < 32; ++i) scr[(2 * i + (lane >> 5)) * 33 + (lane & 31)] = tv[i]; }
    asm volatile("s_waitcnt lgkmcnt(0)" ::: "memory");
    const int c = lane & 7;
#pragma unroll
    for (int j = 0; j < 4; ++j) { const int n = (lane >> 3) + 8 * j; const LAS float* s = scr + (8 * c) * 33 + n;
        u32x4 o; o.x = cvt_pk_bf16(s[0 * 33] * scale, s[1 * 33] * scale); o.y = cvt_pk_bf16(s[2 * 33] * scale, s[3 * 33] * scale);
        o.z = cvt_pk_bf16(s[4 * 33] * scale, s[5 * 33] * scale); o.w = cvt_pk_bf16(s[6 * 33] * scale, s[7 * 33] * scale);
        const int dn = rperm ? rope_perm(n) : n;
        *(u32x4*)(WT + (size_t)(drow0 + dn) * ldt + k0 + 8 * c) = o; }
    asm volatile("s_waitcnt lgkmcnt(0)" ::: "memory");
}
__device__ __forceinline__ void transpose_item_fp8(const float* W, int ldw, int k0, int n0, unsigned char* WT, int ldt, int drow0, bool rperm, float scale, LAS float* scr, int lane) {
    { float tv[32];
#pragma unroll
      for (int i = 0; i < 32; ++i) tv[i] = W[(size_t)(k0 + 2 * i + (lane >> 5)) * ldw + n0 + (lane & 31)];
#pragma unroll
      for (int i = 0; i < 32; ++i) scr[(2 * i + (lane >> 5)) * 33 + (lane & 31)] = tv[i]; }
    asm volatile("s_waitcnt lgkmcnt(0)" ::: "memory");
    const int c = lane & 7;
#pragma unroll
    for (int j = 0; j < 4; ++j) { const int n = (lane >> 3) + 8 * j; const LAS float* sp = scr + (8 * c) * 33 + n;
        u32x2 o; o.x = pk4_fp8(sp[0 * 33] * scale, sp[1 * 33] * scale, sp[2 * 33] * scale, sp[3 * 33] * scale); o.y = pk4_fp8(sp[4 * 33] * scale, sp[5 * 33] * scale, sp[6 * 33] * scale, sp[7 * 33] * scale);
        *(u32x2*)(WT + (size_t)(drow0 + (rperm ? rope_perm(n) : n)) * ldt + k0 + 8 * c) = o; }
    asm volatile("s_waitcnt lgkmcnt(0)" ::: "memory");
}
__device__ __forceinline__ void transpose_item_fp8_k128(const float* W, int ldw, int k0, int n0, unsigned char* WT, int ldt, int drow0, float scale, LAS float* scr, int lane) {
    float v[64];
    const float* p = W + (size_t)(k0 + (lane >> 5)) * ldw + n0 + (lane & 31);
#pragma unroll
    for (int i = 0; i < 64; ++i) v[i] = p[(size_t)(2 * i) * ldw];
#pragma unroll
    for (int i = 0; i < 64; ++i) scr[(2 * i + (lane >> 5)) * 33 + (lane & 31)] = v[i];
    asm volatile("s_waitcnt lgkmcnt(0)" ::: "memory");
    const int c = lane & 7;
#pragma unroll
    for (int j = 0; j < 4; ++j) { const int n = (lane >> 3) + 8 * j; const LAS float* sp = scr + (16 * c) * 33 + n;
        u32x4 o;
        o.x = pk4_fp8(sp[0 * 33] * scale, sp[1 * 33] * scale, sp[2 * 33] * scale, sp[3 * 33] * scale); o.y = pk4_fp8(sp[4 * 33] * scale, sp[5 * 33] * scale, sp[6 * 33] * scale, sp[7 * 33] * scale);
        o.z = pk4_fp8(sp[8 * 33] * scale, sp[9 * 33] * scale, sp[10 * 33] * scale, sp[11 * 33] * scale); o.w = pk4_fp8(sp[12 * 33] * scale, sp[13 * 33] * scale, sp[14 * 33] * scale, sp[15 * 33] * scale);
        *(u32x4*)(WT + (size_t)(drow0 + n) * ldt + k0 + 16 * c) = o; }
    asm volatile("s_waitcnt lgkmcnt(0)" ::: "memory");
}
__device__ __forceinline__ void phase_prologue(const Params& P, LAS unsigned char* lds, int vcu, int G) {
    const int tid = threadIdx.x, lane = tid & 63, wave = __builtin_amdgcn_readfirstlane(tid >> 6);
    float* MOD = WSP(float, WS_MOD);
    if ((int)blockIdx.x < 192) {
        LAS float* s = (LAS float*)lds; LAS float* red = (LAS float*)(lds + 36864);
        for (int idx = tid; idx < 9 * 1024; idx += 512) { const int ci = idx >> 10, k = idx & 1023; const float v = ci < 8 ? P.c[ci * 1024 + k] : P.c_ctx[k]; s[idx] = v / (1.0f + expf(-v)); }
        __syncthreads();
        for (int it = blockIdx.x; it < 192; it += G) {
            const int l = it / 96, n0 = (it % 96) * 64;
            float acc[9];
#pragma unroll
            for (int ci = 0; ci < 9; ++ci) acc[ci] = 0.f;
            const float* w = P.ada_w + (size_t)l * 1024 * 6144 + n0 + lane;
            for (int k0 = wave * 128; k0 < wave * 128 + 128; k0 += 32) {
                float wv[32];
#pragma unroll
                for (int i = 0; i < 32; ++i) wv[i] = w[(size_t)(k0 + i) * 6144];
#pragma unroll
                for (int i = 0; i < 32; ++i)
#pragma unroll
                    for (int ci = 0; ci < 9; ++ci) acc[ci] += s[ci * 1024 + k0 + i] * wv[i]; }
#pragma unroll
            for (int ci = 0; ci < 9; ++ci) red[(wave * 9 + ci) * 64 + lane] = acc[ci];
            __syncthreads();
            for (int idx = tid; idx < 576; idx += 512) { const int ci = idx >> 6, col = idx & 63; float sum = P.ada_b[l * 6144 + n0 + col];
#pragma unroll
                for (int ks = 0; ks < 8; ++ks) sum += red[(ks * 9 + ci) * 64 + col];
                MOD[(size_t)(l * 9 + ci) * 6144 + n0 + col] = sum; }
            __syncthreads();
        }
    }
    if ((int)blockIdx.x == G - 1) {
        float* R = WSP(float, WS_ROPE);
        for (int idx = tid; idx < 1024; idx += 512) { const int pos = idx >> 4, j = idx & 15; const float inv = powf(10000.0f, -(float)j / 16.0f); const float ang = (float)pos * inv;
            R[idx * 2] = cosf(ang); R[idx * 2 + 1] = sinf(ang); }
    }
    __syncthreads();
    LAS float* scr = (LAS float*)(lds + wave * 16896);
    const int gw = vcu * 8 + wave, NGW = G * 8;
    constexpr int I0 = 4096, I1 = 1024, I2 = 640, I3 = 512;
    constexpr int NITEMS = I0 + I1 + I2 + I3;
    for (int it = gw; it < NITEMS; it += NGW) {
        int r = it;
        if (r < I0) { const int kb = r >> 8, nb = r & 255, n0 = nb * 32;
            if (n0 < 2048) transpose_item(P.ret_w_in, 8192, kb * 64, n0, WSP(bf16_t, WS_WQKG), 1024, n0, false, n0 < 1024 ? 0.0625f : 1.0f, scr, lane);
            else if (n0 < 4096) transpose_item(P.ret_w_in, 8192, kb * 64, n0, WSP(bf16_t, WS_WV), 1024, n0 - 2048, false, 1.0f, scr, lane);
            else transpose_item(P.ret_w_in, 8192, kb * 64, n0, WSP(bf16_t, WS_WQKG), 1024, n0 - 2048, false, 1.0f, scr, lane);
            continue; } r -= I0;
        if (r < I1) { const int kb = r >> 5, nb = r & 31; transpose_item(P.ret_w_out, 1024, kb * 64, nb * 32, WSP(bf16_t, WS_WRO), 2048, nb * 32, false, 1.0f, scr, lane); continue; } r -= I1;
        if (r < I2) { const int kb = r / 40, nb = r % 40, n0 = nb * 32;
            transpose_item_fp8(P.swa_w_qkv, 1280, kb * 64, n0, WSP(unsigned char, WS_WQKV), 1024, n0, n0 < 1152, (n0 < 1024 ? 0.125f * LOG2E : 1.0f) * FP8_SW, scr, lane); continue; } r -= I2;
        { const int kb = r >> 5, nb = r & 31; transpose_item_fp8(P.swa_w_out, 1024, kb * 64, nb * 32, WSP(unsigned char, WS_WSO), 1024, nb * 32, false, FP8_SW, scr, lane); }
    }
}
constexpr int MOE_I4 = 16384;
#ifndef CONV_PX
#define CONV_PX 10
#endif
struct MoeItem { const float* src; unsigned char* dst; int ldw, ldt; };
__device__ __forceinline__ MoeItem moe_item(const Params& P, int r) {
    MoeItem m;
    if (r < 2 * MOE_I4) { const int up = r >= MOE_I4; if (up) r -= MOE_I4; const int le = r >> 9, q = r & 511, kb = q >> 6, nb = q & 63, n0 = nb * 32;
        const int drow = (n0 >> 7) * 256 + (n0 & 127) + (up ? 128 : 0);
        m.src = (up ? P.moe_w_up : P.moe_w_gate) + (size_t)le * 1024 * 2048 + (size_t)(kb * 128) * 2048 + n0; m.ldw = 2048;
        m.dst = WSP(unsigned char, WS_GU) + (size_t)le * 4096 * 1024 + (size_t)drow * 1024 + kb * 128; m.ldt = 1024;
    } else { r -= 2 * MOE_I4; const int le = r >> 9, q = r & 511, kb = q >> 5, nb = q & 31;
        m.src = P.moe_w_down + (size_t)le * 2048 * 1024 + (size_t)(kb * 128) * 1024 + nb * 32; m.ldw = 1024;
        m.dst = WSP(unsigned char, WS_DW) + (size_t)le * 1024 * 2048 + (size_t)(nb * 32) * 2048 + kb * 128; m.ldt = 2048; }
    return m;
}
__device__ __forceinline__ void moe_load(const MoeItem& m, int lane, f32x4 (&v)[16]) {
    const float* p = m.src + (size_t)(lane >> 3) * m.ldw + 4 * (lane & 7);
#pragma unroll
    for (int i = 0; i < 16; ++i) v[i] = __builtin_nontemporal_load((const f32x4*)(p + (size_t)(8 * i) * m.ldw));
}
__device__ __forceinline__ void moe_finish(const MoeItem& m, int lane, const f32x4 (&v)[16], LAS float* scr) {
    LAS float* w = scr + (lane >> 3) * 33 + 4 * (lane & 7);
#pragma unroll
    for (int i = 0; i < 16; ++i) { w[i * 264 + 0] = v[i][0]; w[i * 264 + 1] = v[i][1]; w[i * 264 + 2] = v[i][2]; w[i * 264 + 3] = v[i][3]; }
    asm volatile("s_waitcnt lgkmcnt(0)" ::: "memory");
    const int c = lane & 7;
#pragma unroll
    for (int j = 0; j < 4; ++j) { const int n = (lane >> 3) + 8 * j; const LAS float* sp = scr + (16 * c) * 33 + n;
        u32x4 o; const float scale = FP8_SW;
        o.x = pk4_fp8(sp[0 * 33] * scale, sp[1 * 33] * scale, sp[2 * 33] * scale, sp[3 * 33] * scale); o.y = pk4_fp8(sp[4 * 33] * scale, sp[5 * 33] * scale, sp[6 * 33] * scale, sp[7 * 33] * scale);
        o.z = pk4_fp8(sp[8 * 33] * scale, sp[9 * 33] * scale, sp[10 * 33] * scale, sp[11 * 33] * scale); o.w = pk4_fp8(sp[12 * 33] * scale, sp[13 * 33] * scale, sp[14 * 33] * scale, sp[15 * 33] * scale);
        __builtin_nontemporal_store(o, (u32x4*)(m.dst + (size_t)n * m.ldt + 16 * c)); }
    asm volatile("s_waitcnt lgkmcnt(0)" ::: "memory");
}
__device__ __forceinline__ unsigned moe_grab_issue(unsigned* ctr, int lane) {
    unsigned base = 0, z = 0;
    asm volatile("" : "+v"(z));
    if (lane == 0) base = __hip_atomic_fetch_add(ctr + z, 4u, __ATOMIC_RELAXED, __HIP_MEMORY_SCOPE_AGENT);
    return base;
}
__device__ __forceinline__ int moe_grab_resolve(unsigned pend) { const unsigned base = __builtin_amdgcn_readfirstlane(pend); return base >= 3u * MOE_I4 ? -1 : (int)base; }
__device__ __forceinline__ MoeItem moe_item_or_dummy(const Params& P, int r) {
    MoeItem m = moe_item(P, r < 0 ? 0 : r);
    if (r < 0) { m.src = P.moe_w_gate; m.ldw = 0; }
    return m;
}
__device__ __forceinline__ void moe_convert_pool(const Params& P, LAS unsigned char* lds, unsigned* ctr) {
    const int tid = threadIdx.x, lane = tid & 63, wave = __builtin_amdgcn_readfirstlane(tid >> 6);
    LAS float* scr = (LAS float*)(lds + wave * 16896);
    int base = moe_grab_resolve(moe_grab_issue(ctr, lane));
    if (base < 0) return;
    f32x4 va[16], vb[16];
    MoeItem ma = moe_item(P, base), mb;
    moe_load(ma, lane, va);
    for (;;) {
        const unsigned pend = moe_grab_issue(ctr, lane);
        mb = moe_item(P, base + 1); moe_load(mb, lane, vb); moe_finish(ma, lane, va, scr);
        ma = moe_item(P, base + 2); moe_load(ma, lane, va); moe_finish(mb, lane, vb, scr);
        mb = moe_item(P, base + 3); moe_load(mb, lane, vb); moe_finish(ma, lane, va, scr);
        const int nbase = moe_grab_resolve(pend);
        ma = moe_item_or_dummy(P, nbase); moe_load(ma, lane, va); moe_finish(mb, lane, vb, scr);
        if (nbase < 0) break;
        base = nbase;
    }
}

__device__ __forceinline__ void row_load(const float* src, int lane, f32x4 (&v)[4]) {
#pragma unroll
    for (int j = 0; j < 4; ++j) v[j] = *(const f32x4*)(src + 4 * lane + 256 * j);
}
__device__ __forceinline__ void row_load_bf16(const bf16_t* src, int lane, f32x4 (&v)[4]) {
#pragma unroll
    for (int j = 0; j < 4; ++j) { const u32x2 w = *(const u32x2*)(src + 4 * lane + 256 * j); v[j] = (f32x4){bf_lo(w.x), bf_hi(w.x), bf_lo(w.y), bf_hi(w.y)}; }
}
__device__ __forceinline__ float row_rstd(const f32x4 (&v)[4]) {
    float ss = 0.f;
#pragma unroll
    for (int j = 0; j < 4; ++j) ss += (v[j][0] * v[j][0] + v[j][1] * v[j][1]) + (v[j][2] * v[j][2] + v[j][3] * v[j][3]);
    ss = wave_sum(ss);
    return 1.0f / sqrtf(ss * (1.0f / 1024.0f) + 1e-6f);
}
__device__ __forceinline__ void row_modulate(const f32x4 (&v)[4], float rstd, const float* g, const float* sh, const float* sc, int lane, f32x4 (&h)[4]) {
#pragma unroll
    for (int j = 0; j < 4; ++j) { const int c = 4 * lane + 256 * j; const f32x4 gg = *(const f32x4*)(g + c), s1 = *(const f32x4*)(sc + c), s0 = *(const f32x4*)(sh + c);
        h[j] = (v[j] * rstd * gg) * (s1 + 1.0f) + s0; }
}
__device__ __forceinline__ void row_store_bf16(bf16_t* dst, int lane, const f32x4 (&h)[4]) {
#pragma unroll
    for (int j = 0; j < 4; ++j) { u32x2 w; w.x = cvt_pk_bf16(h[j][0], h[j][1]); w.y = cvt_pk_bf16(h[j][2], h[j][3]); *(u32x2*)(dst + 4 * lane + 256 * j) = w; }
}
__device__ __forceinline__ const float* row_src0(const Params& P, int row) { return row < NLAT ? P.x + (size_t)row * D : P.ctx + (size_t)(row - NLAT) * D; }
__device__ __forceinline__ int row_cond(int row) { return row < NLAT ? row / T : 8; }
__device__ __forceinline__ int grp_row(int i, int wave) { const int x = blockIdx.x & 7, k = blockIdx.x >> 3; return i < 8 ? 2048 * x + 64 * k + 8 * i + wave : NLAT + 256 * x + 8 * k + wave; }

__device__ __forceinline__ void phase_norm1_l0(const Params& P, int vcu, int G) {
    const int lane = threadIdx.x & 63, wave = __builtin_amdgcn_readfirstlane(threadIdx.x >> 6);
    const float* MOD = WSP(float, WS_MOD); bf16_t* H = WSP(bf16_t, WS_HBUF);
    f32x4 gv[4], s0v[4], s1v[4]; int curci = -1;
    for (int ri = 0; ri < 9; ++ri) { const int row = grp_row(ri, wave); const int ci = row_cond(row);
        if (ci != curci) { curci = ci; const float* m = MOD + (size_t)ci * 6144;
#pragma unroll
            for (int j = 0; j < 4; ++j) { const int c = 4 * lane + 256 * j; gv[j] = *(const f32x4*)(P.norm1_g + c); s0v[j] = *(const f32x4*)(m + c); s1v[j] = *(const f32x4*)(m + 1024 + c); } }
        f32x4 v[4], h[4]; row_load(row_src0(P, row), lane, v);
        const float rstd = row_rstd(v);
#pragma unroll
        for (int j = 0; j < 4; ++j) h[j] = (v[j] * rstd * gv[j]) * (s1v[j] + 1.0f) + s0v[j];
        row_store_bf16(H + (size_t)row * D, lane, h);
    }
}
template <bool CTX>
__device__ __forceinline__ void phase_norm2_router(const Params& P, LAS unsigned char* lds, int l, int nrows, int G) {
    const int tid = threadIdx.x, lane = tid & 63, wave = __builtin_amdgcn_readfirstlane(tid >> 6);
    const float* MODL = WSP(float, WS_MOD) + (size_t)l * 9 * 6144; unsigned char* H8 = WSP(unsigned char, WS_H2); bf16_t* XR = WSP(bf16_t, WS_XR);
    float* AFFL = WSP(float, WS_AFF); float* AFFC = AFFL + NB * NE * T;
    LAS u32x4* WHf = (LAS u32x4*)lds; LAS u32x4* WLf = (LAS u32x4*)(lds + 32768);
    LAS float* A1 = (LAS float*)(lds + 65536 + wave * 8192); LAS float* A0 = A1 + 1024;
    const int rl = lane & 15, kg = lane >> 4, gx = (int)blockIdx.x & 7, gk = (int)blockIdx.x >> 3;
    const bool ctx = CTX && wave == 4 && gk < 16, have = wave < 4 || ctx;
    const int t = ctx ? 1024 + 16 * gx + gk : 128 * gx + 4 * gk + (wave & 3);
    const int row = 16 * t + rl;
    LAS unsigned char* rowbuf = lds + 106496;
    volatile LAS unsigned* rdy = (volatile LAS unsigned*)(lds + 106496 + 16 * 2064);
    if (CTX && tid == 0) *rdy = 0u;
    u32x4 raw[32];
    if (have && !ctx) {
#pragma unroll
        for (int kk = 0; kk < 32; ++kk) raw[kk] = *(const u32x4*)(XR + (size_t)row * D + 32 * kk + 8 * kg);
    }
    float wf[4][8];
#pragma unroll
    for (int pi = 0; pi < 4; ++pi) { const int p = tid + 512 * pi, pkk = p >> 6, pkg = (p >> 4) & 3, e = p & 15;
        const float* src = P.moe_router + (size_t)l * 16384 + (size_t)(32 * pkk + 8 * pkg) * 16 + e;
#pragma unroll
        for (int i = 0; i < 8; ++i) wf[pi][i] = src[16 * i]; }
#pragma unroll
    for (int pi = 0; pi < 4; ++pi) {
        const int p = tid + 512 * pi;
        float w[8];
#pragma unroll
        for (int i = 0; i < 8; ++i) w[i] = wf[pi][i];
        u32x4 hi, lo;
#pragma unroll
        for (int i = 0; i < 4; ++i) { const unsigned hw = cvt_pk_bf16(w[2 * i], w[2 * i + 1]); hi[i] = hw; lo[i] = cvt_pk_bf16(w[2 * i] - bf_lo(hw), w[2 * i + 1] - bf_hi(hw)); }
        WHf[p] = hi; WLf[p] = lo;
    }
    __syncthreads();
    if (CTX) {
        const int t4 = 1024 + 16 * gx + gk;
        if (wave >= 4 && gk < 16) {
            const int q = wave - 4;
#pragma unroll
            for (int half = 0; half < 2; ++half) {
#pragma unroll
                for (int u = 0; u < 2; ++u) {
                    const int r = 4 * q + 2 * half + u; const size_t grow = (size_t)16 * t4 + r;
                    const float* sp = WSP(float, R_XRP) + (grow - NLAT) * D; f32x4 v[4], t1[4], t2[4], t3[4];
                    row_load(sp, lane, v); row_load(sp + (size_t)NCTX * D, lane, t1); row_load(sp + (size_t)2 * NCTX * D, lane, t2); row_load(sp + (size_t)3 * NCTX * D, lane, t3);
#pragma unroll
                    for (int j = 0; j < 4; ++j) { const f32x4 x = (v[j] + t1[j]) + (t2[j] + t3[j]); u32x2 w; w.x = cvt_pk_bf16(x[0], x[1]); w.y = cvt_pk_bf16(x[2], x[3]);
                        *(u32x2*)(XR + grow * D + 4 * lane + 256 * j) = w; *(LAS u32x2*)(rowbuf + r * 2064 + (4 * lane + 256 * j) * 2) = w; }
                }
                __builtin_amdgcn_sched_barrier(0);
            }
            asm volatile("s_waitcnt lgkmcnt(0)" ::: "memory");
            if (lane == 0) __hip_atomic_fetch_add((LAS unsigned*)rdy, 1u, __ATOMIC_RELAXED, __HIP_MEMORY_SCOPE_WORKGROUP);
        }
    }
    if (!have) return;
    if (ctx) {
        while (*rdy < 4u) __builtin_amdgcn_s_sleep(1);
        asm volatile("" ::: "memory");
#pragma unroll
        for (int kk = 0; kk < 32; ++kk) raw[kk] = *(const LAS u32x4*)(rowbuf + rl * 2064 + 64 * kk + 16 * kg);
    }
    {
        const int cond = ctx ? 8 : (16 * t) / T; const float* g = P.norm2_g + l * 1024; const float* sh = MODL + (size_t)cond * 6144 + 3072; const float* sc = sh + 1024;
#pragma unroll
        for (int j = 0; j < 4; ++j) { const int c = 4 * lane + 256 * j; const f32x4 gg = *(const f32x4*)(g + c), s1 = *(const f32x4*)(sc + c), s0 = *(const f32x4*)(sh + c);
            *(LAS f32x4*)(A1 + c) = gg * (s1 + 1.0f); *(LAS f32x4*)(A0 + c) = s0; }
    }
    float ss = 0.f;
#pragma unroll
    for (int kk = 0; kk < 32; ++kk) {
#pragma unroll
        for (int i = 0; i < 4; ++i) { const float x0 = bf_lo(raw[kk][i]), x1 = bf_hi(raw[kk][i]); ss += x0 * x0 + x1 * x1; } }
    ss = sum_x16x32(ss);
    const float rstd = 1.0f / sqrtf(ss * (1.0f / 1024.0f) + 1e-6f);
#pragma unroll
    for (int kk = 0; kk < 32; ++kk) { asm volatile("" : "+v"(raw[kk]));  }
    asm volatile("s_waitcnt lgkmcnt(0)" ::: "memory");
    f32x4 accA = {0.f, 0.f, 0.f, 0.f}, accB = {0.f, 0.f, 0.f, 0.f};
    const LAS float* a1p = A1 + 8 * kg; const LAS float* a0p = A0 + 8 * kg;
    unsigned char* hrow2 = H8 + (size_t)row * D + 16 * (kg >> 1) + 32 * (kg & 1); u32x2 f8prev = {0u, 0u};
#pragma unroll
    for (int kk = 0; kk < 32; ++kk) {
        const f32x4 m0 = *(const LAS f32x4*)(a1p + 32 * kk), m1 = *(const LAS f32x4*)(a1p + 32 * kk + 4), d0 = *(const LAS f32x4*)(a0p + 32 * kk), d1 = *(const LAS f32x4*)(a0p + 32 * kk + 4);
        const u32x4 bh = WHf[kk * 64 + lane], bl = WLf[kk * 64 + lane];
        float hv[8];
#pragma unroll
        for (int i = 0; i < 4; ++i) { const float x0 = bf_lo(raw[kk][i]) * rstd, x1 = bf_hi(raw[kk][i]) * rstd;
            const float mm0 = i < 2 ? m0[2 * i] : m1[2 * i - 4], mm1 = i < 2 ? m0[2 * i + 1] : m1[2 * i - 3], dd0 = i < 2 ? d0[2 * i] : d1[2 * i - 4], dd1 = i < 2 ? d0[2 * i + 1] : d1[2 * i - 3];
            hv[2 * i] = x0 * mm0 + dd0; hv[2 * i + 1] = x1 * mm1 + dd1; }
        u32x2 f8; f8.x = pk4_fp8(hv[0] * FP8_SX, hv[1] * FP8_SX, hv[2] * FP8_SX, hv[3] * FP8_SX); f8.y = pk4_fp8(hv[4] * FP8_SX, hv[5] * FP8_SX, hv[6] * FP8_SX, hv[7] * FP8_SX);
        if (kk & 1) *(u32x4*)(hrow2 + 32 * (kk - 1)) = pair_rows16(f8prev, f8);
        f8prev = f8;
        u32x4 ah, al;
#pragma unroll
        for (int i = 0; i < 4; ++i) { const unsigned hw = cvt_pk_bf16(hv[2 * i], hv[2 * i + 1]); ah[i] = hw; al[i] = cvt_pk_bf16(hv[2 * i] - bf_lo(hw), hv[2 * i + 1] - bf_hi(hw)); }
        accA = __builtin_amdgcn_mfma_f32_16x16x32_bf16(__builtin_bit_cast(bf16x8, bh), __builtin_bit_cast(bf16x8, ah), accA, 0, 0, 0);
        accB = __builtin_amdgcn_mfma_f32_16x16x32_bf16(__builtin_bit_cast(bf16x8, bl), __builtin_bit_cast(bf16x8, ah), accB, 0, 0, 0);
        accB = __builtin_amdgcn_mfma_f32_16x16x32_bf16(__builtin_bit_cast(bf16x8, bh), __builtin_bit_cast(bf16x8, al), accB, 0, 0, 0);
        if (kk & 1) __builtin_amdgcn_sched_barrier(0);
    }
    const f32x4 lg = accA + accB;
    float mx = max_x16x32(fmaxf(fmaxf(lg[0], lg[1]), fmaxf(lg[2], lg[3])));
    f32x4 ex;
#pragma unroll
    for (int i = 0; i < 4; ++i) ex[i] = expf(lg[i] - mx);
    const float sum = sum_x16x32((ex[0] + ex[1]) + (ex[2] + ex[3]));
    const float inv = 1.0f / sum;
    if (!ctx) { const int b = row / T, tt = row % T;
#pragma unroll
        for (int i = 0; i < 4; ++i) AFFL[(size_t)(b * 16 + 4 * kg + i) * T + tt] = ex[i] * inv; }
    else { const int r2 = row - NLAT, b = r2 / TC, tt = r2 % TC;
#pragma unroll
        for (int i = 0; i < 4; ++i) AFFC[(size_t)(b * 16 + 4 * kg + i) * TC + tt] = ex[i] * inv; }
}
template <int NIT>
__device__ __forceinline__ void topk_gather(const unsigned char* H, unsigned char* XS, LAS const int* sel, int rowbase, int s_first, int lane) {
    u32x4 rb[2][8];
#pragma unroll
    for (int q = 0; q < 8; ++q) { const int src = __builtin_amdgcn_readfirstlane(sel[s_first + q]); rb[0][q] = *((const u32x4*)(H + (size_t)src * D) + lane); }
#pragma unroll
    for (int j = 0; j < NIT; ++j) {
        if (j + 1 < NIT) {
#pragma unroll
            for (int q = 0; q < 8; ++q) { const int src = __builtin_amdgcn_readfirstlane(sel[s_first + 64 * (j + 1) + q]); rb[(j + 1) & 1][q] = *((const u32x4*)(H + (size_t)src * D) + lane); }
        }
#pragma unroll
        for (int q = 0; q < 8; ++q) *((u32x4*)(XS + (size_t)(rowbase + s_first + 64 * j + q) * D) + lane) = rb[j & 1][q];
    }
}
__device__ __forceinline__ void phase_topk(const Params& P, LAS unsigned char* lds, int l, int G) {
    const int tid = threadIdx.x, lane = tid & 63, wave = __builtin_amdgcn_readfirstlane(tid >> 6);
    const float* AFFL = WSP(float, WS_AFF); const float* AFFC = AFFL + NB * NE * T;
    int* TOK = WSP(int, WS_TOK); float* GATE = WSP(float, WS_GATE); int* INV = WSP(int, WS_INV);
    LAS unsigned* cnt = (LAS unsigned*)lds;
    LAS int* sel = (LAS int*)(lds + 256);
    const int nitems = l == 0 ? 256 : 128, rows_per_e = l == 0 ? 2304 : 2048;
    for (int wk = blockIdx.x; wk < 256; wk += G) {
        const int it = l == 0 ? wk : (wk & 127), part = l == 0 ? 0 : (wk >> 7);
        const bool isctx = it >= 128; const int be = it & 127, b = be >> 4, e = be & 15;
        const int n = isctx ? TC : T; const unsigned cap = isctx ? 32u : 256u;
        const float* a = isctx ? AFFC + (size_t)be * TC : AFFL + (size_t)be * T;
        float av[4] = {0.f, 0.f, 0.f, 0.f}; unsigned key[4] = {0u, 0u, 0u, 0u};
        if (tid * 4 < n) { const f32x4 v = *(const f32x4*)(a + tid * 4);
#pragma unroll
            for (int k = 0; k < 4; ++k) { av[k] = v[k]; key[k] = __float_as_uint(v[k]); } }
        unsigned thr = 0u; int par = 0;
        for (int bit = 30; bit >= 0; --bit) {
            const unsigned cand = thr | (1u << bit); unsigned c = 0u;
#pragma unroll
            for (int k = 0; k < 4; ++k) c += (unsigned)__popcll(__ballot(key[k] >= cand));
            if (lane == 0) cnt[par * 8 + wave] = c;
            __syncthreads();
            unsigned tot = 0u;
#pragma unroll
            for (int w2 = 0; w2 < 8; ++w2) tot += cnt[par * 8 + w2];
            if (tot >= cap) thr = cand;
            par ^= 1;
        }
        unsigned packed = 0u;
#pragma unroll
        for (int k = 0; k < 4; ++k) packed += (key[k] > thr ? 1u : 0u) + (key[k] == thr ? 0x10000u : 0u);
        unsigned incl = packed;
#pragma unroll
        for (int o = 1; o < 64; o <<= 1) { const unsigned t2 = __shfl_up(incl, o); if (lane >= o) incl += t2; }
        if (lane == 63) cnt[16 + wave] = incl;
        __syncthreads();
        unsigned woff = 0u, total = 0u;
#pragma unroll
        for (int w2 = 0; w2 < 8; ++w2) { const unsigned t2 = cnt[16 + w2]; total += t2; if (w2 < wave) woff += t2; }
        const unsigned excl = incl - packed + woff;
        const unsigned ngt = total & 0xffffu, need_eq = cap - ngt;
        unsigned pg = excl & 0xffffu, pe = excl >> 16;
        const int rowbase = e * rows_per_e + (isctx ? 2048 + b * 32 : b * 256);
        const int tokbase = isctx ? NLAT + b * TC : b * T;
        if (tid * 4 < n) {
#pragma unroll
            for (int k = 0; k < 4; ++k) {
                const int tokrow = tokbase + tid * 4 + k; int slot = -1;
                if (key[k] > thr) { slot = (int)pg; ++pg; }
                else if (key[k] == thr) { if (pe < need_eq) slot = (int)(ngt + pe); ++pe; }
                if (slot >= 0) sel[slot] = tokrow;
                if (part == 0) { if (slot >= 0) { GATE[rowbase + slot] = av[k]; INV[(size_t)tokrow * 16 + e] = rowbase + slot; } else INV[(size_t)tokrow * 16 + e] = -1; }
            }
        }
        __syncthreads();
        const unsigned char* H = WSP(unsigned char, WS_H2);
        unsigned char* XS = WSP(unsigned char, R_XS);
        if (l == 1) topk_gather<2>(H, XS, sel, rowbase, part * 128 + wave * 8, lane);
        else if (!isctx) topk_gather<4>(H, XS, sel, rowbase, wave * 8, lane);
        else if (wave < 4) topk_gather<1>(H, XS, sel, rowbase, wave * 8, lane);
        __syncthreads();
    }
}
__device__ __forceinline__ void phase_gather(const Params& P, int nrows, bool fp8, int vcu, int G) {
    const int lane = threadIdx.x & 63, wave = __builtin_amdgcn_readfirstlane(threadIdx.x >> 6);
    const int* TOK = WSP(int, WS_TOK); const bf16_t* H = WSP(bf16_t, WS_HBUF); bf16_t* XS = WSP(bf16_t, R_XS);
    if (fp8) {
        unsigned char* XS8 = WSP(unsigned char, R_XS);
        for (int r = vcu * 8 + wave; r < nrows; r += G * 8) {
            const int src = TOK[r]; const u32x4* sp = (const u32x4*)(H + (size_t)src * D); const u32x4 a = sp[2 * lane], b = sp[2 * lane + 1];
            u32x4 o; o.x = pk4_fp8(bf_lo(a.x) * FP8_SX, bf_hi(a.x) * FP8_SX, bf_lo(a.y) * FP8_SX, bf_hi(a.y) * FP8_SX); o.y = pk4_fp8(bf_lo(a.z) * FP8_SX, bf_hi(a.z) * FP8_SX, bf_lo(a.w) * FP8_SX, bf_hi(a.w) * FP8_SX);
            o.z = pk4_fp8(bf_lo(b.x) * FP8_SX, bf_hi(b.x) * FP8_SX, bf_lo(b.y) * FP8_SX, bf_hi(b.y) * FP8_SX); o.w = pk4_fp8(bf_lo(b.z) * FP8_SX, bf_hi(b.z) * FP8_SX, bf_lo(b.w) * FP8_SX, bf_hi(b.w) * FP8_SX);
            *(u32x4*)(XS8 + (size_t)r * D + 16 * lane) = o;
        }
        return;
    }
    for (int r = vcu * 8 + wave; r < nrows; r += G * 8) {
        const int src = TOK[r]; const u32x4* s = (const u32x4*)(H + (size_t)src * D); u32x4* d = (u32x4*)(XS + (size_t)r * D);
        const u32x4 a = s[lane], b = s[lane + 64]; d[lane] = a; d[lane + 64] = b;
    }
}
__device__ __forceinline__ void phase_combine(const Params& P, int l, int nrows, bool final_, int vcu, int G) {
    const int lane = threadIdx.x & 63, wave = __builtin_amdgcn_readfirstlane(threadIdx.x >> 6), c0 = 16 * lane;
    const float* MOD = WSP(float, WS_MOD); bf16_t* XR = WSP(bf16_t, WS_XR); const int* INV = WSP(int, WS_INV); const unsigned char* YS = WSP(unsigned char, R_YS); unsigned char* H = WSP(unsigned char, WS_HBUF);
    f32x4 g2v[4], w0v[4], w1v[4], w2v[4]; int curci = -1;
    const int nr = nrows > NLAT ? 9 : 8;
    int row = grp_row(0, wave);
    u32x4 x0 = *(const u32x4*)(XR + (size_t)row * D + c0), x1 = *(const u32x4*)(XR + (size_t)row * D + c0 + 8);
    int myinv = INV[(size_t)row * 16 + (lane & 15)];
    for (int ri = 0; ri < nr; ++ri) {
        const int rown = grp_row(ri + 1 < nr ? ri + 1 : ri, wave);
        const u32x4 nx0 = *(const u32x4*)(XR + (size_t)rown * D + c0), nx1 = *(const u32x4*)(XR + (size_t)rown * D + c0 + 8);
        const int ninv = INV[(size_t)rown * 16 + (lane & 15)];
        const int ci = row_cond(row);
        if (ci != curci) { curci = ci;
            const float* g2 = MOD + (size_t)(l * 9 + ci) * 6144 + 5120 + c0;
#pragma unroll
            for (int i = 0; i < 4; ++i) g2v[i] = *(const f32x4*)(g2 + 4 * i);
            if (final_) {
#pragma unroll
                for (int i = 0; i < 4; ++i) w0v[i] = *(const f32x4*)(P.final_g + c0 + 4 * i);
            } else { const float* m = MOD + (size_t)((l + 1) * 9 + ci) * 6144 + c0; const float* gn = P.norm1_g + (l + 1) * 1024 + c0;
#pragma unroll
                for (int i = 0; i < 4; ++i) { w0v[i] = *(const f32x4*)(gn + 4 * i); w1v[i] = *(const f32x4*)(m + 4 * i); w2v[i] = *(const f32x4*)(m + 1024 + 4 * i); } }
        }
        float v[16], a[16];
#pragma unroll
        for (int i = 0; i < 4; ++i) { v[2 * i] = bf_lo(x0[i]); v[2 * i + 1] = bf_hi(x0[i]); v[8 + 2 * i] = bf_lo(x1[i]); v[9 + 2 * i] = bf_hi(x1[i]); }
#pragma unroll
        for (int i = 0; i < 16; ++i) a[i] = 0.f;
        unsigned mask = (unsigned)__builtin_amdgcn_ballot_w64(myinv >= 0) & 0xffffu;
        if (row < NLAT) {
            while (mask != 0) {
                const int e0 = __builtin_ctz(mask); mask &= mask - 1;
                const int r0 = __builtin_amdgcn_readlane(myinv, e0);
                int r1 = r0; float s1 = 0.f;
                if (mask != 0) { const int e1 = __builtin_ctz(mask); mask &= mask - 1; r1 = __builtin_amdgcn_readlane(myinv, e1); s1 = 1.0f / FP8_SO; }
                const u32x4 wa = *(const u32x4*)(YS + (size_t)r0 * D + c0), wb = *(const u32x4*)(YS + (size_t)r1 * D + c0);
#pragma unroll
                for (int i = 0; i < 4; ++i) { const f32x2 lo = __builtin_amdgcn_cvt_pk_f32_fp8((int)wa[i], false), hi = __builtin_amdgcn_cvt_pk_f32_fp8((int)wa[i], true);
                    a[4 * i] += lo[0] * (1.0f / FP8_SO); a[4 * i + 1] += lo[1] * (1.0f / FP8_SO); a[4 * i + 2] += hi[0] * (1.0f / FP8_SO); a[4 * i + 3] += hi[1] * (1.0f / FP8_SO); }
#pragma unroll
                for (int i = 0; i < 4; ++i) { const f32x2 lo = __builtin_amdgcn_cvt_pk_f32_fp8((int)wb[i], false), hi = __builtin_amdgcn_cvt_pk_f32_fp8((int)wb[i], true);
                    a[4 * i] += lo[0] * s1; a[4 * i + 1] += lo[1] * s1; a[4 * i + 2] += hi[0] * s1; a[4 * i + 3] += hi[1] * s1; }
            }
        } else {
            while (mask != 0) {
                const int e0 = __builtin_ctz(mask); mask &= mask - 1;
                const int r = __builtin_amdgcn_readlane(myinv, e0);
                const u32x4 w = *(const u32x4*)(YS + (size_t)r * D + c0);
                const int ee = r / 2304, i2 = ee * 256 + (r - ee * 2304 - 2048);
                u32x4 y0[3], y1[3];
#pragma unroll
                for (int sl = 0; sl < 3; ++sl) { const bf16_t* yp = WSP(bf16_t, R_YS2) + ((size_t)sl * 4096 + i2) * D + c0; y0[sl] = *(const u32x4*)yp; y1[sl] = *(const u32x4*)(yp + 8); }
#pragma unroll
                for (int i = 0; i < 4; ++i) { const f32x2 lo = __builtin_amdgcn_cvt_pk_f32_fp8((int)w[i], false), hi = __builtin_amdgcn_cvt_pk_f32_fp8((int)w[i], true);
                    a[4 * i] += lo[0] * (1.0f / FP8_SO); a[4 * i + 1] += lo[1] * (1.0f / FP8_SO); a[4 * i + 2] += hi[0] * (1.0f / FP8_SO); a[4 * i + 3] += hi[1] * (1.0f / FP8_SO); }
#pragma unroll
                for (int sl = 0; sl < 3; ++sl)
#pragma unroll
                    for (int i = 0; i < 4; ++i) { a[2 * i] += bf_lo(y0[sl][i]); a[2 * i + 1] += bf_hi(y0[sl][i]); a[8 + 2 * i] += bf_lo(y1[sl][i]); a[9 + 2 * i] += bf_hi(y1[sl][i]); }
            }
        }
        float ss = 0.f;
#pragma unroll
        for (int i = 0; i < 4; ++i) { const f32x4 gg = g2v[i];
#pragma unroll
            for (int k = 0; k < 4; ++k) { v[4 * i + k] += gg[k] * a[4 * i + k]; ss += v[4 * i + k] * v[4 * i + k]; } }
        ss = wave_sum(ss);
        const float rstd = 1.0f / sqrtf(ss * (1.0f / 1024.0f) + 1e-6f);
        if (final_) {
#pragma unroll
            for (int i = 0; i < 4; ++i) { const f32x4 gg = w0v[i];
                *(f32x4*)(P.out + (size_t)row * D + c0 + 4 * i) = (f32x4){v[4 * i] * rstd * gg[0], v[4 * i + 1] * rstd * gg[1], v[4 * i + 2] * rstd * gg[2], v[4 * i + 3] * rstd * gg[3]}; }
        } else {
            u32x4 x0, x1;
#pragma unroll
            for (int i = 0; i < 4; ++i) { x0[i] = cvt_pk_bf16(v[2 * i], v[2 * i + 1]); x1[i] = cvt_pk_bf16(v[8 + 2 * i], v[9 + 2 * i]); }
            *(u32x4*)(XR + (size_t)row * D + c0) = x0; *(u32x4*)(XR + (size_t)row * D + c0 + 8) = x1;
            u32x4 h8;
#pragma unroll
            for (int i = 0; i < 4; ++i) { const f32x4 gg = w0v[i], s0 = w1v[i], s1 = w2v[i];
                float hq[4];
#pragma unroll
                for (int k = 0; k < 4; ++k) hq[k] = ((v[4 * i + k] * rstd * gg[k]) * (s1[k] + 1.0f) + s0[k]) * FP8_SX;
                h8[i] = pk4_fp8(hq[0], hq[1], hq[2], hq[3]); }
            *(u32x4*)(H + (size_t)row * D + c0) = h8;
        }
        row = rown; x0 = nx0; x1 = nx1; myinv = ninv;
    }
}
__device__ __forceinline__ void phase_gate(const Params& P, int vcu, int G) {
    const int lane = threadIdx.x & 63, wave = __builtin_amdgcn_readfirstlane(threadIdx.x >> 6);
    const bf16_t* QKG = WSP(bf16_t, R_QKG); bf16_t* OF = WSP(bf16_t, R_OF); const bf16_t* OB = WSP(bf16_t, R_OB); const float* GN = WSP(float, WS_GNST);
    for (int hh = 0; hh < 4; ++hh) {
        const int col = 512 * hh + 8 * lane;
        const f32x4 nf0 = *(const f32x4*)(P.ret_gn_f + col), nf1 = *(const f32x4*)(P.ret_gn_f + col + 4), nb0 = *(const f32x4*)(P.ret_gn_b + col), nb1 = *(const f32x4*)(P.ret_gn_b + col + 4);
        const float gnf[8] = {nf0[0], nf0[1], nf0[2], nf0[3], nf1[0], nf1[1], nf1[2], nf1[3]}, gnb[8] = {nb0[0], nb0[1], nb0[2], nb0[3], nb1[0], nb1[1], nb1[2], nb1[3]};
        for (int ri = 0; ri < 9; ++ri) { const int row = grp_row(ri, wave);
            float mu[2], rs[2];
#pragma unroll
            for (int d = 0; d < 2; ++d) { const f32x4* st = (const f32x4*)(GN + ((size_t)(d * NROW + row) * 4 + hh) * 8); const f32x4 s0 = st[0], s1 = st[1];
                const float sum = (s0[0] + s0[2]) + (s1[0] + s1[2]), sq = (s0[1] + s0[3]) + (s1[1] + s1[3]);
                mu[d] = sum * (1.0f / 512.0f); const float var = fmaxf(sq * (1.0f / 512.0f) - mu[d] * mu[d], 0.f); rs[d] = 1.0f / sqrtf(var + 1e-6f); }
            const u32x4 of = *(const u32x4*)(OF + (size_t)row * 2048 + col), ob = *(const u32x4*)(OB + (size_t)row * 2048 + col);
            const u32x4 gf = *(const u32x4*)(QKG + (size_t)row * QKG_LD + 2048 + col), gb = *(const u32x4*)(QKG + (size_t)row * QKG_LD + 4096 + col);
            float y[8];
#pragma unroll
            for (int q = 0; q < 4; ++q) {
                const float f0 = bf_lo(of[q]), f1 = bf_hi(of[q]), b0 = bf_lo(ob[q]), b1 = bf_hi(ob[q]);
                const float gf0 = bf_lo(gf[q]), gf1 = bf_hi(gf[q]), gb0 = bf_lo(gb[q]), gb1 = bf_hi(gb[q]);
                y[2 * q] = silu_f(gf0) * ((f0 - mu[0]) * rs[0] * gnf[2 * q]) + silu_f(gb0) * ((b0 - mu[1]) * rs[1] * gnb[2 * q]);
                y[2 * q + 1] = silu_f(gf1) * ((f1 - mu[0]) * rs[0] * gnf[2 * q + 1]) + silu_f(gb1) * ((b1 - mu[1]) * rs[1] * gnb[2 * q + 1]);
            }
            u32x4 w; w.x = cvt_pk_bf16(y[0], y[1]); w.y = cvt_pk_bf16(y[2], y[3]); w.z = cvt_pk_bf16(y[4], y[5]); w.w = cvt_pk_bf16(y[6], y[7]);
            *(u32x4*)(OF + (size_t)row * 2048 + col) = w;
        }
    }
}

typedef short v4i16_t __attribute__((ext_vector_type(4)));
__device__ __forceinline__ s16x4 lds_tr(LAS unsigned char* p) { return __builtin_bit_cast(s16x4, __builtin_amdgcn_ds_read_tr16_b64_v4i16((LAS v4i16_t*)p)); }
__device__ __forceinline__ s16x4 lds_tr_asm(LAS unsigned char* p) { s16x4 d; asm volatile("ds_read_b64_tr_b16 %0, %1" : "=v"(d) : "v"(p)); return d; }
#define SCAN_TRWAIT(N_, A_) asm volatile("s_waitcnt lgkmcnt(" #N_ ")" : "+v"(A_[0]), "+v"(A_[1]), "+v"(A_[2]), "+v"(A_[3]), "+v"(A_[4]), "+v"(A_[5]), "+v"(A_[6]), "+v"(A_[7]))
__device__ __forceinline__ bf16x8 cat8(s16x4 lo, s16x4 hi) { return __builtin_shufflevector(lo, hi, 0, 1, 2, 3, 4, 5, 6, 7); }
__device__ __forceinline__ bf16x8 pack8(const f32x4 a, const f32x4 b) { u32x4 w; w.x = cvt_pk_bf16(a[0], a[1]); w.y = cvt_pk_bf16(a[2], a[3]); w.z = cvt_pk_bf16(b[0], b[1]); w.w = cvt_pk_bf16(b[2], b[3]); return __builtin_bit_cast(bf16x8, w); }
__device__ __forceinline__ int fswz_qk(int row) { return ((row >> 2) & 1) | (((row >> 1) & 1) << 1) | (((row >> 3) & 1) << 2); }
__device__ __forceinline__ void scan_dma(const bf16_t* QKG, int R0, int h, int t, LAS unsigned char* slot, int w, int lane) {
#pragma unroll
    for (int i = 0; i < 2; ++i) { const int q = w * 2 + i, row = 8 * q + (lane >> 3), cc = (lane & 7) ^ fswz_qk(row);
        const bf16_t* src = QKG + (size_t)(R0 + row) * QKG_LD + h * 256 + 64 * t + cc * 8;
        __builtin_amdgcn_global_load_lds((const unsigned*)src, (LAS unsigned*)(slot + q * 1024), 16, 0, 0);
        __builtin_amdgcn_global_load_lds((const unsigned*)(src + 1024), (LAS unsigned*)(slot + 16384 + q * 1024), 16, 0, 0); }
}
#define SCAN_SB() __builtin_amdgcn_sched_barrier(0)
template <int TT>
__device__ __forceinline__ void scan_tile_a(LAS unsigned char* slot, const f32x4 (&sacc)[16], f32x4 (&oacc)[8], f32x4 (&pacc)[8], const int (&qoff)[2][2], int w) {
    LAS unsigned char* Qt = slot; LAS unsigned char* Kt = slot + 16384;
    bf16x8 kA[2], sA[2];
    s16x4 qb[3][4];
#pragma unroll
    for (int ks2 = 0; ks2 < 2; ++ks2) {
        kA[ks2] = cat8(*(const LAS s16x4*)(Kt + w * 2048 + qoff[ks2][0]), *(const LAS s16x4*)(Kt + w * 2048 + qoff[ks2][1]));
        sA[ks2] = pack8(sacc[4 * TT + 2 * ks2], sacc[4 * TT + 2 * ks2 + 1]); }
#pragma unroll
    for (int q = 0; q < 4; ++q) { qb[0][q] = *(const LAS s16x4*)(Qt + qoff[q >> 1][q & 1]); qb[1][q] = *(const LAS s16x4*)(Qt + 2048 + qoff[q >> 1][q & 1]); }
    SCAN_SB();
#pragma unroll
    for (int it = 0; it < 8; ++it) {
        if (it < 6) {
#pragma unroll
            for (int q = 0; q < 4; ++q) qb[(it + 2) % 3][q] = *(const LAS s16x4*)(Qt + (it + 2) * 2048 + qoff[q >> 1][q & 1]); }
        const bf16x8 q0 = cat8(qb[it % 3][0], qb[it % 3][1]), q1 = cat8(qb[it % 3][2], qb[it % 3][3]);
        pacc[it] = __builtin_amdgcn_mfma_f32_16x16x32_bf16(kA[0], q0, pacc[it], 0, 0, 0);
        oacc[it] = __builtin_amdgcn_mfma_f32_16x16x32_bf16(sA[0], q0, oacc[it], 0, 0, 0);
        pacc[it] = __builtin_amdgcn_mfma_f32_16x16x32_bf16(kA[1], q1, pacc[it], 0, 0, 0);
        oacc[it] = __builtin_amdgcn_mfma_f32_16x16x32_bf16(sA[1], q1, oacc[it], 0, 0, 0);
        SCAN_SB();
    }
}
template <int TT>
__device__ __forceinline__ void scan_tile_b(LAS unsigned char* slot, f32x4 (&sacc)[16], const bf16x8 (&vd)[4], const int (&vbase)[2], const int (&doff)[4], float cd) {
    LAS unsigned char* Kt = slot + 16384;
    s16x4 ab[3][8];
#pragma unroll
    for (int k2 = 0; k2 < 2; ++k2)
#pragma unroll
        for (int dt = 0; dt < 4; ++dt) { ab[k2][2 * dt] = lds_tr_asm(Kt + k2 * 4096 + vbase[0] + doff[dt]); ab[k2][2 * dt + 1] = lds_tr_asm(Kt + k2 * 4096 + vbase[1] + doff[dt]); }
#pragma unroll
    for (int dt = 0; dt < 4; ++dt) sacc[4 * TT + dt] = sacc[4 * TT + dt] * cd;
    SCAN_SB();
#pragma unroll
    for (int ks = 0; ks < 4; ++ks) {
        if (ks < 2) {
#pragma unroll
            for (int dt = 0; dt < 4; ++dt) { ab[(ks + 2) % 3][2 * dt] = lds_tr_asm(Kt + (ks + 2) * 4096 + vbase[0] + doff[dt]); ab[(ks + 2) % 3][2 * dt + 1] = lds_tr_asm(Kt + (ks + 2) * 4096 + vbase[1] + doff[dt]); } }
        if (ks < 2) SCAN_TRWAIT(15, ab[ks % 3]); else if (ks == 2) SCAN_TRWAIT(8, ab[ks % 3]); else SCAN_TRWAIT(0, ab[ks % 3]);
#pragma unroll
        for (int dt = 0; dt < 4; ++dt) sacc[4 * TT + dt] = __builtin_amdgcn_mfma_f32_16x16x32_bf16(cat8(ab[ks % 3][2 * dt], ab[ks % 3][2 * dt + 1]), vd[ks], sacc[4 * TT + dt], 0, 0, 0);
        SCAN_SB();
    }
}
__device__ __forceinline__ void scan_step_sync(bool dma_issued) {
    if (dma_issued) asm volatile("s_waitcnt vmcnt(4) lgkmcnt(0)" ::: "memory"); else asm volatile("s_waitcnt vmcnt(0) lgkmcnt(0)" ::: "memory");
    __builtin_amdgcn_s_barrier(); asm volatile("" ::: "memory");
}
__device__ __forceinline__ void phase_scan(const Params& P, LAS unsigned char* lds, int vcu, int G) {
    const int tid = threadIdx.x, lane = tid & 63, w = __builtin_amdgcn_readfirstlane(tid >> 6), l15 = lane & 15, g = lane >> 4;
    const bf16_t* QKG = WSP(bf16_t, R_QKG); const bf16_t* VT = WSP(bf16_t, R_VT); float* GN = WSP(float, WS_GNST);
    LAS unsigned char* PT = lds + 98304;
    LAS float* ST = (LAS float*)(lds + 98304 + 34816);
    LAS float* kdT = (LAS float*)(lds + 98304 + 34816 + 8192);
    LAS float* qdT = kdT + 128;
    LAS float* dcT = kdT + 256;
    int qoff[2][2], vbase[2], doff[4];
#pragma unroll
    for (int ks2 = 0; ks2 < 2; ++ks2)
#pragma unroll
        for (int hf = 0; hf < 2; ++hf) qoff[ks2][hf] = l15 * 128 + (((4 * ks2 + 2 * hf + (g >> 1)) ^ fswz_qk(l15)) * 16) + 8 * (g & 1);
    { const int qq = l15 >> 2, p = lane & 3, f0 = ((qq >> 1) << 1) | ((g & 1) << 2);
#pragma unroll
      for (int t = 0; t < 2; ++t) vbase[t] = (8 * g + 4 * t + qq) * 128 + (((p >> 1) ^ t) * 16) + 8 * (p & 1);
#pragma unroll
      for (int dt = 0; dt < 4; ++dt) doff[dt] = 32 * (dt ^ (f0 >> 1)); }
    if (vcu < 256) {
        const int unit = vcu;
        const int bh = unit >> 3, b = bh >> 2, h = bh & 3, dir = (unit >> 2) & 1, s = unit & 3;
        const int n0 = h * 512 + s * 128;
        bf16_t* OX = WSP(bf16_t, dir ? R_OB : R_OF);
        const float xd = (dir ? P.ret_decay_b : P.ret_decay_f)[h];
        const float lg2 = -log1pf(expf(-xd)) * LOG2E;
        const float cd = exp2f(128.0f * lg2);
        f32x4 sacc[16], oacc[8], pacc[8];
#pragma unroll
        for (int i = 0; i < 16; ++i) sacc[i] = (f32x4){0.f, 0.f, 0.f, 0.f};
#pragma unroll
        for (int i = 0; i < 8; ++i) { oacc[i] = (f32x4){0.f, 0.f, 0.f, 0.f}; pacc[i] = (f32x4){0.f, 0.f, 0.f, 0.f}; }
        int cs = 0;
        { const int R00 = dir ? NLAT + b * TC + 128 : NLAT + b * TC; scan_dma(QKG, R00, h, 0, lds, w, lane); scan_dma(QKG, R00, h, 1, lds + 32768, w, lane); }
        if (tid < 128) { kdT[tid] = exp2f((float)(dir ? tid : 127 - tid) * lg2); qdT[tid] = exp2f((float)(dir ? 128 - tid : tid + 1) * lg2); dcT[tid] = exp2f((float)tid * lg2); }
        scan_step_sync(true);
#define SCAN_ROTATE() do { const int ncs = cs == 2 ? 0 : cs + 1; const int dl = (ncs - cs) * 32768; cs = ncs; \
            qoff[0][0] += dl; qoff[0][1] += dl; qoff[1][0] += dl; qoff[1][1] += dl; vbase[0] += dl; vbase[1] += dl; } while (0)
#define SCAN_DSLOT() (lds + (cs == 0 ? 65536 : (cs == 1 ? 0 : 32768)))
        for (int c = 0; c < 18; ++c) {
            int R0, R1;
            if (!dir) { R0 = c < 2 ? NLAT + b * TC + c * 128 : b * T + (c - 2) * 128; R1 = (c + 1) < 2 ? NLAT + b * TC + (c + 1) * 128 : b * T + (c - 1) * 128; }
            else { R0 = c < 2 ? NLAT + b * TC + (1 - c) * 128 : b * T + (17 - c) * 128; R1 = (c + 1) < 2 ? NLAT + b * TC + (0 - c) * 128 : b * T + (16 - c) * 128; }
            const bool more = c < 17;
            bf16x8 vf[4], vd[4];
            const bf16_t* vsrc = VT + (size_t)(n0 + 16 * w + l15) * NROW + R0 + 8 * g;
#pragma unroll
            for (int ks = 0; ks < 4; ++ks) vf[ks] = *(const bf16x8*)(vsrc + 32 * ks);
            asm volatile("" ::: "memory");
            scan_dma(QKG, R0, h, 2, SCAN_DSLOT(), w, lane);
            scan_tile_a<0>(lds, sacc, oacc, pacc, qoff, w);
#pragma unroll
            for (int ks = 0; ks < 4; ++ks) { const u32x4 raw = __builtin_bit_cast(u32x4, vf[ks]); u32x4 o;
                const f32x4 ka = *(const LAS f32x4*)(kdT + 32 * ks + 8 * g), kb = *(const LAS f32x4*)(kdT + 32 * ks + 8 * g + 4);
                o[0] = cvt_pk_bf16(bf_lo(raw[0]) * ka[0], bf_hi(raw[0]) * ka[1]); o[1] = cvt_pk_bf16(bf_lo(raw[1]) * ka[2], bf_hi(raw[1]) * ka[3]);
                o[2] = cvt_pk_bf16(bf_lo(raw[2]) * kb[0], bf_hi(raw[2]) * kb[1]); o[3] = cvt_pk_bf16(bf_lo(raw[3]) * kb[2], bf_hi(raw[3]) * kb[3]);
                vd[ks] = __builtin_bit_cast(bf16x8, o); }
            scan_tile_b<0>(lds, sacc, vd, vbase, doff, cd);
            scan_step_sync(true); SCAN_ROTATE();
            scan_dma(QKG, R0, h, 3, SCAN_DSLOT(), w, lane);
            scan_tile_a<1>(lds, sacc, oacc, pacc, qoff, w); scan_tile_b<1>(lds, sacc, vd, vbase, doff, cd);
            scan_step_sync(true); SCAN_ROTATE();
            if (more) scan_dma(QKG, R1, h, 0, SCAN_DSLOT(), w, lane);
            scan_tile_a<2>(lds, sacc, oacc, pacc, qoff, w); scan_tile_b<2>(lds, sacc, vd, vbase, doff, cd);
            scan_step_sync(more); SCAN_ROTATE();
            { const bf16_t* vs2 = vsrc; asm volatile("" : "+v"(vs2));
#pragma unroll
              for (int ks = 0; ks < 4; ++ks) vf[ks] = *(const bf16x8*)(vs2 + 32 * ks); }
            asm volatile("" ::: "memory");
            if (more) scan_dma(QKG, R1, h, 1, SCAN_DSLOT(), w, lane);
            scan_tile_a<3>(lds, sacc, oacc, pacc, qoff, w); scan_tile_b<3>(lds, sacc, vd, vbase, doff, cd);
            int d0 = dir ? (16 * w + 4 * g) - l15 : l15 - (16 * w + 4 * g); asm volatile("" : "+v"(d0));
            const int sgn = dir ? -1 : 1;
            LAS unsigned char* ptw = PT + l15 * 272 + (16 * w + 4 * g) * 2;
            LAS unsigned char* ptr_ = PT + l15 * 272 + 16 * g;
            const LAS float* qdp = qdT + l15;
            LAS float* stp = ST + (w * 128 + l15) * 2;
            bf16_t* oxp = OX + (size_t)(R0 + l15 + 16 * (g & 1)) * 2048 + n0 + 16 * w + 8 * (g >> 1);
#pragma unroll
            for (int it = 0; it < 8; ++it) { float pv[4];
#pragma unroll
                for (int r = 0; r < 4; ++r) { const int diff = d0 + sgn * (16 * it - r);
                    const float dv = __builtin_amdgcn_exp2f((float)diff * lg2);
                    pv[r] = diff >= 0 ? pacc[it][r] * dv : 0.f; }
                u32x2 wv; wv.x = cvt_pk_bf16(pv[0], pv[1]); wv.y = cvt_pk_bf16(pv[2], pv[3]);
                *(LAS u32x2*)(ptw + it * 4352) = wv; }
            wg_sync_lds();
#pragma unroll
            for (int it = 0; it < 8; ++it) oacc[it] = oacc[it] * qdp[16 * it];
            {
                bf16x8 pq[3];
                pq[0] = *(const LAS bf16x8*)(ptr_); pq[1] = *(const LAS bf16x8*)(ptr_ + 4352);
#pragma unroll
                for (int st = 0; st < 32; ++st) { const int ks = st >> 3, it = st & 7;
                    if (st + 2 < 32) { const int k2 = (st + 2) >> 3, i2 = (st + 2) & 7; pq[(st + 2) % 3] = *(const LAS bf16x8*)(ptr_ + i2 * 4352 + k2 * 64); }
                    oacc[it] = __builtin_amdgcn_mfma_f32_16x16x32_bf16(vf[ks], pq[st % 3], oacc[it], 0, 0, 0);
                    SCAN_SB(); }
#pragma unroll
                for (int it = 0; it < 8; ++it) pacc[it] = (f32x4){0.f, 0.f, 0.f, 0.f};
            }
#pragma unroll
            for (int it = 0; it < 8; ++it) {
                const f32x4 o = oacc[it];
                float s1 = (o[0] + o[1]) + (o[2] + o[3]), s2 = (o[0] * o[0] + o[1] * o[1]) + (o[2] * o[2] + o[3] * o[3]);
                s1 = sum_x16x32(s1); s2 = sum_x16x32(s2);
                if (g == 0) { stp[32 * it] = s1; stp[32 * it + 1] = s2; } }
            scan_step_sync(more); SCAN_ROTATE();
#pragma unroll
            for (int itp = 0; itp < 4; ++itp) { u32x2 wq[2];
#pragma unroll
                for (int mi = 0; mi < 2; ++mi) { const f32x4 o = oacc[2 * itp + mi]; wq[mi].x = cvt_pk_bf16(o[0], o[1]); wq[mi].y = cvt_pk_bf16(o[2], o[3]); oacc[2 * itp + mi] = (f32x4){0.f, 0.f, 0.f, 0.f}; }
                *(u32x4*)(oxp + (size_t)itp * 32 * 2048) = pair_rows16(wq[0], wq[1]); }
            if (tid < 128) { float s1 = 0.f, s2 = 0.f;
#pragma unroll
                for (int w2 = 0; w2 < 8; ++w2) { s1 += ST[(w2 * 128 + tid) * 2]; s2 += ST[(w2 * 128 + tid) * 2 + 1]; }
                float* gp = GN + ((size_t)(dir * NROW + R0 + tid) * 4 + h) * 8 + s * 2; gp[0] = s1; gp[1] = s2; }
        }
#undef SCAN_ROTATE
#undef SCAN_DSLOT
        wg_sync();
    }
}

__device__ __forceinline__ int fswz_k(int row) { return (row >> 1) & 7; }
__device__ __forceinline__ int fswz_v(int row) { return (((row >> 1) & 3) << 1) | ((row >> 3) & 1); }
__device__ __forceinline__ void attn_dma(const bf16_t* QKV, int rowbase, int kvh, LAS unsigned char* slot, int w, int lane) {
    const int row = 8 * w + (lane >> 3), pc = lane & 7;
    const bf16_t* src = QKV + (size_t)(rowbase + row) * QKV_LD + kvh * 64;
    __builtin_amdgcn_global_load_lds((const unsigned*)(src + 1024 + ((pc ^ fswz_k(row)) * 8)), (LAS unsigned*)(slot + w * 1024), 16, 0, 0);
    __builtin_amdgcn_global_load_lds((const unsigned*)(src + 1152 + ((pc ^ fswz_v(row)) * 8)), (LAS unsigned*)(slot + 8192 + w * 1024), 16, 0, 0);
}
__device__ __forceinline__ void phase_attn(const Params& P, LAS unsigned char* lds, int vcu, int G) {
    const int tid = threadIdx.x, lane = tid & 63, w = __builtin_amdgcn_readfirstlane(tid >> 6), l15 = lane & 15, g = lane >> 4;
    const bf16_t* QKV = WSP(bf16_t, R_QKV); bf16_t* O1 = WSP(bf16_t, R_O1);
    int koff[2], vtb, vdoff[4];
#pragma unroll
    for (int ks = 0; ks < 2; ++ks) koff[ks] = l15 * 128 + (((4 * ks + g) ^ fswz_k(l15)) * 16);
    { const int qq = l15 >> 2, p = lane & 3, fv = fswz_v(4 * g + qq);
      vtb = (4 * g + qq) * 128 + (((p >> 1) ^ (fv & 1)) * 16) + 8 * (p & 1);
#pragma unroll
      for (int dt = 0; dt < 4; ++dt) vdoff[dt] = 32 * (dt ^ (fv >> 1)); }
    if (w >= 4) __builtin_amdgcn_s_setprio(1);
    bf16x8 qf[4][2];
    for (int it = 0; it < 2; ++it) { const int ui = 64 * ((int)blockIdx.x & 7) + 32 * it + ((int)blockIdx.x >> 3);
        const int b = ui >> 6, kvh = (ui >> 5) & 1, qb = ui & 31, q0 = 64 * qb, hq = kvh * 8 + w;
        const int wt_lo = qb >= 2 ? 0 : 2 - qb, wt_hi = (33 - qb) < 4 ? (33 - qb) : 4, nt = 4 + (wt_hi - wt_lo + 1);
        if (it == 0) {
#pragma unroll
            for (int qt = 0; qt < 4; ++qt)
#pragma unroll
                for (int ks = 0; ks < 2; ++ks) qf[qt][ks] = *(const bf16x8*)(QKV + (size_t)(b * T + q0 + 16 * qt + l15) * QKV_LD + hq * 64 + 32 * ks + 8 * g);
        }
        const int tbase = it * nt;
        float mrun[4], lrun[4]; f32x4 oacc[4][4];
#pragma unroll
        for (int qt = 0; qt < 4; ++qt) { mrun[qt] = -1e30f; lrun[qt] = 0.f;
#pragma unroll
            for (int dt = 0; dt < 4; ++dt) oacc[dt][qt] = (f32x4){0.f, 0.f, 0.f, 0.f}; }
        if (it == 0) { attn_dma(QKV, NLAT + b * TC, kvh, lds, w, lane); wg_sync(); }
        for (int ti = 0; ti < nt; ++ti) {
            LAS unsigned char* slot = lds + ((tbase + ti) & 1) * 16384;
            const int wt = wt_lo + ti - 4;
            if (ti + 1 < nt) { const int tn = ti + 1; const int rb = tn < 4 ? NLAT + b * TC + 64 * tn : b * T + q0 - 128 + 64 * (wt_lo + tn - 4);
                attn_dma(QKV, rb, kvh, lds + ((tbase + tn) & 1) * 16384, w, lane); }
            else if (it == 0) attn_dma(QKV, NLAT + b * TC, 1, lds + ((tbase + nt) & 1) * 16384, w, lane);
            f32x4 sc[4][4];
#pragma unroll
            for (int kt = 0; kt < 4; ++kt) {
                const bf16x8 a0 = *(const LAS bf16x8*)(slot + kt * 2048 + koff[0]), a1 = *(const LAS bf16x8*)(slot + kt * 2048 + koff[1]);
#pragma unroll
                for (int qt = 0; qt < 4; ++qt) { f32x4 z = (f32x4){0.f, 0.f, 0.f, 0.f};
                    z = __builtin_amdgcn_mfma_f32_16x16x32_bf16(a0, qf[qt][0], z, 0, 0, 0);
                    sc[kt][qt] = __builtin_amdgcn_mfma_f32_16x16x32_bf16(a1, qf[qt][1], z, 0, 0, 0); } }
            __builtin_amdgcn_sched_barrier(0);
            if (it == 0 && ti == nt - 1) {
#pragma unroll
                for (int qt = 0; qt < 4; ++qt)
#pragma unroll
                    for (int ks = 0; ks < 2; ++ks) qf[qt][ks] = *(const bf16x8*)(QKV + (size_t)(b * T + q0 + 16 * qt + l15) * QKV_LD + (8 + w) * 64 + 32 * ks + 8 * g);
            }
            const int mtype = (ti >= 4 && wt == 0) ? 1 : ((ti >= 4 && wt == 4) ? 2 : 0);
            if (mtype != 0) {
#pragma unroll
                for (int qt = 0; qt < 4; ++qt) { const int qi = 16 * qt + l15;
#pragma unroll
                    for (int kt = 0; kt < 4; ++kt)
#pragma unroll
                        for (int r = 0; r < 4; ++r) { const int kl = 16 * kt + 4 * g + r; const bool dead = (mtype == 1) ? (kl < qi) : (kl > qi); if (dead) sc[kt][qt][r] = -INFINITY; } }
            }
            bf16x8 pf[4][2];
#pragma unroll
            for (int qt = 0; qt < 4; ++qt) {
                float mx = -1e30f;
#pragma unroll
                for (int kt = 0; kt < 4; ++kt)
#pragma unroll
                    for (int r = 0; r < 4; ++r) mx = fmaxf(mx, sc[kt][qt][r]);
                mx = max_x16x32(mx);
                const float mxl = mx;
                if (__builtin_amdgcn_ballot_w64(mxl > mrun[qt] + 8.0f) != 0) {
                    const float mnew = fmaxf(mrun[qt], mxl), alpha = __builtin_amdgcn_exp2f(mrun[qt] - mnew); mrun[qt] = mnew; lrun[qt] = lrun[qt] * alpha;
#pragma unroll
                    for (int dt = 0; dt < 4; ++dt) oacc[dt][qt] = oacc[dt][qt] * alpha;
                }
                const float mref = mrun[qt];
                f32x4 ls4 = {0.f, 0.f, 0.f, 0.f};
#pragma unroll
                for (int kt = 0; kt < 4; ++kt) { const f32x4 t = sc[kt][qt] - mref; f32x4 pv;
#pragma unroll
                    for (int r = 0; r < 4; ++r) pv[r] = __builtin_amdgcn_exp2f(t[r]);
                    sc[kt][qt] = pv; ls4 = ls4 + pv; }
                lrun[qt] += (ls4[0] + ls4[1]) + (ls4[2] + ls4[3]);
                pf[qt][0] = pack8(sc[0][qt], sc[1][qt]); pf[qt][1] = pack8(sc[2][qt], sc[3][qt]);
            }
            __builtin_amdgcn_sched_barrier(0);
            {
                s16x4 vq[3][2];
#pragma unroll
                for (int s0 = 0; s0 < 2; ++s0) { const int dt = s0 >> 1, kk = s0 & 1;
                    vq[s0][0] = lds_tr(slot + 8192 + kk * 4096 + vtb + vdoff[dt]); vq[s0][1] = lds_tr(slot + 8192 + kk * 4096 + 2048 + vtb + vdoff[dt]); }
#pragma unroll
                for (int st = 0; st < 8; ++st) { const int dt = st >> 1, kk = st & 1;
                    if (st + 2 < 8) { const int d2 = (st + 2) >> 1, k2 = (st + 2) & 1;
                        vq[(st + 2) % 3][0] = lds_tr(slot + 8192 + k2 * 4096 + vtb + vdoff[d2]); vq[(st + 2) % 3][1] = lds_tr(slot + 8192 + k2 * 4096 + 2048 + vtb + vdoff[d2]); }
                    const bf16x8 a = cat8(vq[st % 3][0], vq[st % 3][1]);
#pragma unroll
                    for (int qt = 0; qt < 4; ++qt) oacc[dt][qt] = __builtin_amdgcn_mfma_f32_16x16x32_bf16(a, pf[qt][kk], oacc[dt][qt], 0, 0, 0);
                    __builtin_amdgcn_sched_barrier(0);
                }
            }
            wg_sync();
        }
        const float sink2 = P.swa_sink[hq] * LOG2E;
#pragma unroll
        for (int qt = 0; qt < 4; ++qt) {
            float l = sum_x16x32(lrun[qt]); l += __builtin_amdgcn_exp2f(sink2 - mrun[qt]);
            const float inv = 1.0f / l;
#pragma unroll
            for (int dt = 0; dt < 4; ++dt) { const f32x4 o = oacc[dt][qt] * (inv * FP8_SX);
                *(unsigned*)((unsigned char*)O1 + (size_t)(b * T + q0 + 16 * qt + l15) * D + hq * 64 + 16 * dt + 4 * g) = pk4_fp8(o[0], o[1], o[2], o[3]); }
        }
    }
    __builtin_amdgcn_s_setprio(0);
}

constexpr int NPHASE = 21;
#ifndef PH_MASK
#define PH_MASK 0xffffffffu
#endif
#define IN(k) ((((PH_MASK) >> (k)) & 1u) && lo <= (k) && (k) < hi)
#define BOTH(k) (IN(k) && IN((k) + 1))
#define GRID_BAR() do { if (MK_ONE_LAUNCH) xcd_barrier(bar); } while (0)
#define GRP_BAR() do { if (MK_ONE_LAUNCH) grp_barrier(WSP(unsigned, WS_CTL), MISC); } while (0)

__global__ void __launch_bounds__(512, 2) mega_fwd(Params P) {
    extern __shared__ __attribute__((aligned(16))) unsigned char lds_raw[];
    LAS unsigned char* lds = (LAS unsigned char*)lds_raw;
    const int tid = threadIdx.x, G = gridDim.x;
    const int bx = blockIdx.x, vcu = (G % 8 == 0) ? (bx % 8) * (G / 8) + bx / 8 : bx;
    volatile LAS unsigned* MISC = (volatile LAS unsigned*)(lds + LDS_MISC);
    if (tid < 4) MISC[tid] = 0u;
    __syncthreads();
    XcdBarrier bar; bar.bar = WSP(unsigned, WS_CTL); bar.x = 0; bar.st = MISC;
    if (MK_ONE_LAUNCH) { bar = xcd_barrier_post(WSP(unsigned, WS_CTL), MISC); if (tid == 0) __hip_atomic_store(WSP(unsigned, WS_CTL) + GB_XTAB + bx, xb_xcc_id() + 1u, __ATOMIC_RELAXED, __HIP_MEMORY_SCOPE_AGENT); }
    const int lo = P.ph_lo, hi = P.ph_hi;

    if (IN(0)) { phase_prologue(P, lds, vcu, G); if (BOTH(0)) GRID_BAR(); }
    if (IN(1)) { phase_norm1_l0(P, vcu, G); if (BOTH(1)) GRP_BAR(); }
    if (IN(2)) {
        const int kx = bx >> 3; const bool split = (G == 256), conv = split && (kx >= 32 - CONV_PX);
        if (!conv) {
            SchedIn S{WSP(bf16_t, WS_HBUF), WSP(bf16_t, WS_WQKG), WSP(bf16_t, WS_WV), 32 - CONV_PX, bx & 7, kx};
            EpiIn E{WSP(bf16_t, R_QKG), WSP(bf16_t, R_VT)};
            pg8::gemm_phase<EpiIn, SchedIn>(lds, pg8::Gemm{1024, 1024}, S, E);
            __syncthreads();
        }
        moe_convert_pool(P, lds, WSP(unsigned, WS_CTL) + 8192);
        if (BOTH(2)) GRP_BAR();
    }
    if (IN(3)) { phase_scan(P, lds, vcu, G); if (BOTH(3)) GRP_BAR(); }
    if (IN(4)) { phase_gate(P, vcu, G); if (BOTH(4)) GRP_BAR(); }
    if (IN(5)) {
        SchedRO S{WSP(bf16_t, R_OF), WSP(bf16_t, WS_WRO), G, bx};
        EpiRes E{P.x, P.ctx, nullptr, WSP(float, WS_MOD) + 2048, WSP(bf16_t, WS_XR), WSP(float, R_XRP), 1.0f};
        pg8::gemm_phase<EpiRes, SchedRO>(lds, pg8::Gemm{2048, 2048}, S, E);
        if (BOTH(5)) GRP_BAR();
    }
    if (IN(6)) { phase_norm2_router<true>(P, lds, 0, NROW, G); if (BOTH(6)) GRID_BAR(); }
    if (IN(7)) { phase_topk(P, lds, 0, G); if (IN(9)) GRP_BAR(); }
    if (IN(9)) {
        SchedGrouped S{WSP(bf16_t, R_XS), WSP(bf16_t, WS_GU), 512, 512, 9, 16, G, bx};
        EpiGU E{WSP(bf16_t, R_HID), 1};
        pg8::gemm_phase<EpiGU, SchedGrouped, true>(lds, pg8::Gemm{512, 512}, S, E);
        if (BOTH(9)) GRP_BAR();
    }
    if (IN(10)) {
        SchedDown0 S{WSP(bf16_t, R_HID), WSP(bf16_t, WS_DW), G, bx, 1024};
        EpiDown E{WSP(bf16_t, R_YS), WSP(float, WS_GATE), WSP(bf16_t, R_YS2), 1.0f / (FP8_SH * FP8_SW)};
        pg8::gemm_phase<EpiDown, SchedDown0, true>(lds, pg8::Gemm{1024, 1024}, S, E);
        if (BOTH(10)) GRID_BAR();
    }
    if (IN(11)) { phase_combine(P, 0, NROW, false, vcu, G); if (BOTH(11)) GRP_BAR(); }
    if (IN(12)) {
        SchedQkv S{WSP(bf16_t, WS_HBUF), WSP(bf16_t, WS_WQKV), G, bx};
        EpiQkv E{WSP(bf16_t, R_QKV), WSP(float, WS_ROPE), 1.0f / (FP8_SX * FP8_SW)};
        pg8::gemm_phase<EpiQkv, SchedQkv, true>(lds, pg8::Gemm{512, 512}, S, E);
        if (BOTH(12)) GRP_BAR();
    }
    if (IN(13)) { phase_attn(P, lds, vcu, G); if (BOTH(13)) GRP_BAR(); }
    if (IN(14)) {
        SchedPlain S{WSP(bf16_t, R_O1), WSP(bf16_t, WS_WSO), 512, 512, 64, 4, G, bx};
        EpiRes E{nullptr, nullptr, WSP(bf16_t, WS_XR), WSP(float, WS_MOD) + 9 * 6144 + 2048, WSP(bf16_t, WS_XR), nullptr, 1.0f / (FP8_SX * FP8_SW)};
        pg8::gemm_phase<EpiRes, SchedPlain, true>(lds, pg8::Gemm{512, 512}, S, E);
        if (BOTH(14)) GRP_BAR();
    }
    if (IN(15)) { phase_norm2_router<false>(P, lds, 1, NLAT, G); if (BOTH(15)) GRID_BAR(); }
    if (IN(16)) { phase_topk(P, lds, 1, G); if (IN(18)) GRP_BAR(); }
    if (IN(18)) {
        SchedGrouped S{WSP(bf16_t, R_XS), (const bf16_t*)(WSP(unsigned char, WS_GU) + (size_t)NE * 4096 * 1024), 512, 512, 8, 16, G, bx};
        EpiGU E{WSP(bf16_t, R_HID), 1};
        pg8::gemm_phase<EpiGU, SchedGrouped, true>(lds, pg8::Gemm{512, 512}, S, E);
        if (BOTH(18)) GRP_BAR();
    }
    if (IN(19)) {
        SchedGrouped S{WSP(bf16_t, R_HID), (const bf16_t*)(WSP(unsigned char, WS_DW) + (size_t)NE * 1024 * 2048), 1024, 1024, 8, 4, G, bx};
        EpiDown E{WSP(bf16_t, R_YS), WSP(float, WS_GATE), nullptr, 1.0f / (FP8_SH * FP8_SW)};
        pg8::gemm_phase<EpiDown, SchedGrouped, true>(lds, pg8::Gemm{1024, 1024}, S, E);
        if (BOTH(19)) GRID_BAR();
    }
    if (IN(20)) { phase_combine(P, 1, NLAT, true, vcu, G); }
}

#ifndef DBG_STOP
#define DBG_STOP -1
#endif
__global__ void dbg_dump(const float* src, float* out, size_t n) { for (size_t i = (size_t)blockIdx.x * blockDim.x + threadIdx.x; i < n; i += (size_t)gridDim.x * blockDim.x) out[i] = src[i]; }
__global__ void dbg_dump_bf16(const bf16_t* src, size_t nsrc, size_t mul, float* out, size_t n) { for (size_t i = (size_t)blockIdx.x * blockDim.x + threadIdx.x; i < n; i += (size_t)gridDim.x * blockDim.x) out[i] = __uint_as_float(((unsigned)src[(i * mul) % nsrc]) << 16); }
#ifndef DBG_SRC
#define DBG_SRC R_OF
#define DBG_N ((size_t)NROW * 4096)
#define DBG_MUL 5
#endif
extern "C" void kernel_launch(void* const* d_in, const int* in_sizes, int n_in, void* d_out, int out_size, void* d_ws, size_t ws_size, hipStream_t stream) {
    static int grid = 0;
    if (grid == 0) {
        if (n_in != 22 || ws_size < WS_END) { fprintf(stderr, "kernel_launch: expected 22 inputs and >= %zu bytes of workspace, got %d / %zu\n", (size_t)WS_END, n_in, ws_size); grid = -1; return; }
        int dev = 0, cus = 0, per_cu = 0;
        if (hipGetDevice(&dev) != hipSuccess || hipDeviceGetAttribute(&cus, hipDeviceAttributeMultiprocessorCount, dev) != hipSuccess) { grid = -1; return; }
        if (hipFuncSetAttribute((const void*)mega_fwd, hipFuncAttributeMaxDynamicSharedMemorySize, LDS_BYTES) != hipSuccess) { fprintf(stderr, "kernel_launch: hipFuncSetAttribute failed\n"); grid = -1; return; }
        if (hipOccupancyMaxActiveBlocksPerMultiprocessor(&per_cu, (const void*)mega_fwd, 512, LDS_BYTES) != hipSuccess || per_cu < 1) { fprintf(stderr, "kernel_launch: occupancy query says %d\n", per_cu); }
        (void)hipGetLastError();
        if (cus < 256) { fprintf(stderr, "kernel_launch: built for a 256-CU device, found %d\n", cus); grid = -1; return; }
        grid = 256;
    }
    if (grid < 0) return;
    (void)hipMemsetAsync((char*)d_ws + WS_CTL, 0, CTL_BYTES, stream);
    Params p{};
    p.x = (const float*)d_in[0]; p.c = (const float*)d_in[1]; p.ctx = (const float*)d_in[2]; p.c_ctx = (const float*)d_in[3]; p.ada_w = (const float*)d_in[4]; p.ada_b = (const float*)d_in[5];
    p.norm1_g = (const float*)d_in[6]; p.norm2_g = (const float*)d_in[7]; p.final_g = (const float*)d_in[8];
    p.ret_w_in = (const float*)d_in[9]; p.ret_decay_f = (const float*)d_in[10]; p.ret_decay_b = (const float*)d_in[11]; p.ret_gn_f = (const float*)d_in[12]; p.ret_gn_b = (const float*)d_in[13]; p.ret_w_out = (const float*)d_in[14];
    p.swa_w_qkv = (const float*)d_in[15]; p.swa_sink = (const float*)d_in[16]; p.swa_w_out = (const float*)d_in[17];
    p.moe_router = (const float*)d_in[18]; p.moe_w_gate = (const float*)d_in[19]; p.moe_w_up = (const float*)d_in[20]; p.moe_w_down = (const float*)d_in[21];
    p.out = (float*)d_out; p.ws = (unsigned char*)d_ws;
#if MK_ONE_LAUNCH
    p.ph_lo = 0; p.ph_hi = NPHASE;
    hipLaunchKernelGGL(mega_fwd, dim3(grid), dim3(512), LDS_BYTES, stream, p);
#else
    const int last = (DBG_STOP >= 0) ? DBG_STOP : NPHASE - 1;
    for (int ph = 0; ph <= last; ++ph) { p.ph_lo = ph; p.ph_hi = ph + 1; hipLaunchKernelGGL(mega_fwd, dim3(grid), dim3(512), LDS_BYTES, stream, p); }
    if (DBG_STOP >= 0 && DBG_SRC != 0) hipLaunchKernelGGL(dbg_dump_bf16, dim3(1024), dim3(256), 0, stream, (const bf16_t*)((unsigned char*)d_ws + (size_t)(DBG_SRC)), (size_t)(DBG_N), (size_t)(DBG_MUL), (float*)d_out, (size_t)NLAT * D);
    else if (DBG_STOP >= 0) hipLaunchKernelGGL(dbg_dump, dim3(1024), dim3(256), 0, stream, (const float*)((unsigned char*)d_ws + WS_XR), (float*)d_out, (size_t)NLAT * D);
#endif
}
```
